# Optimizing an MI355X kernel written in HIP

```python
import math
import jax, jax.numpy as jnp
from jax import lax
import numpy as np

D_MODEL = 1024
BATCH = 16
SEQ = 2048
DEPTH = 1

MIX_WIDTH = D_MODEL
SB_WIDTH = D_MODEL // 2
SB_HEADS = 8
SB_HEAD_DIM = SB_WIDTH // SB_HEADS
POOL_WIDTH = MIX_WIDTH - SB_WIDTH
POOL_WINDOWS = (2, 4, 8, 16)
POOL_GROUPS = len(POOL_WINDOWS)
POOL_GROUP_DIM = POOL_WIDTH // POOL_GROUPS
IN_WIDTH = 3 * SB_WIDTH + POOL_WIDTH
D_FF = -(-8 * D_MODEL // (3 * 256)) * 256
Q_BLOCK = 128
N_MOD = 6
EPS = 1e-6

kernel_name = "hybrid_stickbreak_pool_block"


def rmsnorm(x, g):
    xf = x.astype(jnp.float32)
    y = xf * lax.rsqrt(jnp.mean(xf * xf, axis=-1, keepdims=True) + EPS)
    return (y * g.astype(jnp.float32)).astype(x.dtype)


def stick_breaking_attention(q, k, v):
    S = q.shape[2]
    inv_sqrt = 1.0 / math.sqrt(q.shape[-1])
    outs = []
    for i in range(S // Q_BLOCK):
        L = (i + 1) * Q_BLOCK
        qb = q[:, :, i * Q_BLOCK:L].astype(jnp.float32)
        kb = k[:, :, :L].astype(jnp.float32)
        vb = v[:, :, :L].astype(jnp.float32)
        z = jnp.einsum('bhqd,bhkd->bhqk', qb, kb) * inv_sqrt
        t_idx = i * Q_BLOCK + jnp.arange(Q_BLOCK)[:, None]
        s_idx = jnp.arange(L)[None, :]
        mask = s_idx < t_idx
        log1m = jnp.where(mask, -jax.nn.softplus(z), 0.0)
        after = lax.cumsum(log1m, axis=3, reverse=True) - log1m
        logw = jax.nn.log_sigmoid(z) + after
        w = jnp.where(mask, jnp.exp(jnp.where(mask, logw, 0.0)), 0.0)
        outs.append(jnp.einsum('bhqk,bhkd->bhqd', w, vb))
    return jnp.concatenate(outs, axis=2).astype(v.dtype)


def pooling_mixer(u, w_pool, pool_scale):
    B, S, P = u.shape
    uf = u.astype(jnp.float32)
    cs = jnp.concatenate([jnp.zeros((B, 1, P), jnp.float32), jnp.cumsum(uf, axis=1)], axis=1)
    t = jnp.arange(S)
    parts = []
    for g, win in enumerate(POOL_WINDOWS):
        sl = slice(g * POOL_GROUP_DIM, (g + 1) * POOL_GROUP_DIM)
        lo = jnp.maximum(t + 1 - win, 0)
        cnt = (t + 1 - lo).astype(jnp.float32)
        csg = cs[..., sl]
        mean = (csg[:, 1:] - csg[:, lo]) / cnt[None, :, None]
        parts.append(mean - uf[..., sl])
    pooled = jnp.stack(parts, axis=2)
    y = jnp.einsum('bsgc,gcd->bsgd', pooled, w_pool.astype(jnp.float32)).reshape(B, S, P)
    return (y * pool_scale.astype(jnp.float32)).astype(u.dtype)


def setup_inputs(seed: int = 0) -> dict:
    key = jax.random.key(seed)
    ks = jax.random.split(key, 16)
    f32 = jnp.float32

    def nrm(k, shape, fan_in):
        return jax.random.normal(k, shape, f32) * fan_in ** -0.5

    def gain(k):
        return 1.0 + 0.05 * jax.random.normal(k, (DEPTH, D_MODEL), f32)

    return {
        "x": jax.random.normal(ks[0], (BATCH, SEQ, D_MODEL), f32),
        "c": jax.random.normal(ks[1], (BATCH, D_MODEL), f32),
        "w_cond": nrm(ks[2], (DEPTH, D_MODEL, N_MOD * D_MODEL), D_MODEL),
        "b_cond": 0.01 * jax.random.normal(ks[3], (DEPTH, N_MOD * D_MODEL), f32),
        "g_mix_pre": gain(ks[4]),
        "g_mix_post": gain(ks[5]),
        "w_in": nrm(ks[6], (DEPTH, D_MODEL, IN_WIDTH), D_MODEL),
        "w_pool": nrm(ks[7], (DEPTH, POOL_GROUPS, POOL_GROUP_DIM, POOL_GROUP_DIM), POOL_GROUP_DIM),
        "pool_scale": 1.0 + 0.1 * jax.random.normal(ks[8], (DEPTH, POOL_WIDTH), f32),
        "w_out": nrm(ks[9], (DEPTH, MIX_WIDTH, D_MODEL), MIX_WIDTH),
        "g_ffn_pre": gain(ks[10]),
        "g_ffn_post": gain(ks[11]),
        "w_gate": nrm(ks[12], (DEPTH, D_MODEL, D_FF), D_MODEL),
        "w_up": nrm(ks[13], (DEPTH, D_MODEL, D_FF), D_MODEL),
        "w_down": nrm(ks[14], (DEPTH, D_FF, D_MODEL), D_FF),
    }


def reference(x, c, w_cond, b_cond, g_mix_pre, g_mix_post, w_in, w_pool, pool_scale,
              w_out, g_ffn_pre, g_ffn_post, w_gate, w_up, w_down):
    B, S, D = x.shape
    for l in range(DEPTH):
        mod = jax.nn.silu(c) @ w_cond[l] + b_cond[l]
        shift_m, scale_m, gate_m, shift_f, scale_f, gate_f = [
            m[:, None, :] for m in jnp.split(mod, N_MOD, axis=-1)]

        h = rmsnorm(x, g_mix_pre[l]) * (1.0 + scale_m) + shift_m
        proj = h @ w_in[l]
        q, k, v, u = jnp.split(proj, [SB_WIDTH, 2 * SB_WIDTH, 3 * SB_WIDTH], axis=-1)
        to_heads = lambda a: a.reshape(B, S, SB_HEADS, SB_HEAD_DIM).transpose(0, 2, 1, 3)
        attn = stick_breaking_attention(to_heads(q), to_heads(k), to_heads(v))
        attn = attn.transpose(0, 2, 1, 3).reshape(B, S, SB_WIDTH)
        pool = pooling_mixer(u, w_pool[l], pool_scale[l])
        mix = jnp.concatenate([attn, pool], axis=-1) @ w_out[l]
        x = x + gate_m * rmsnorm(mix, g_mix_post[l])

        h = rmsnorm(x, g_ffn_pre[l]) * (1.0 + scale_f) + shift_f
        f = (jax.nn.silu(h @ w_gate[l]) * (h @ w_up[l])) @ w_down[l]
        x = x + gate_f * rmsnorm(f, g_ffn_post[l])
    return x
```

```cpp
#include <hip/hip_runtime.h>
#include <hip/hip_cooperative_groups.h>
#include <cstdio>
#include <cstdint>
namespace cg = cooperative_groups;
namespace pg8 {
#define PG8_LAS __attribute__((address_space(3)))
typedef unsigned short bf16_t;
typedef short bf16x8 __attribute__((ext_vector_type(8)));
typedef float f32x4 __attribute__((ext_vector_type(4)));
typedef unsigned u32x4 __attribute__((ext_vector_type(4)));
constexpr int BM = 256, BK = 64, HALF = 128, HTB = HALF * BK * 2  , STAGE_BYTES = 8 * HTB, NXCD = 8, WGM = 8;

__host__ __device__ __forceinline__ int lds_byte(int r, int c) { const int st = (r >> 4) * 2 + (c >> 5), rr = r & 15, cc = c & 31, ob = rr * 64 + cc * 2; return st * 1024 + (ob ^ (((ob >> 9) & 1) << 5)); }
__host__ __device__ __forceinline__ void stage_rc(int b, int& R, int& C) { const int st = b / 1024, sb = b % 1024, swz = sb ^ (((sb >> 9) & 1) << 5); R = (st >> 1) * 16 + swz / 64; C = (st & 1) * 32 + (swz % 64) / 2; }
__host__ __device__ __forceinline__ int perm32(int rho) { const int n = rho >> 4, i = rho & 15; return 8 * (i >> 2) + 4 * n + (i & 3); }

struct Unit { int pm, pn; };
struct Gemm { const bf16_t* A; const bf16_t* Bt; int M, N, K; };

struct StaticOrder {
    int nM, nN, nwg, G, c;
    __host__ __device__ void init(int M, int N, int G_, int c_) { nM = M / BM; nN = N / BM; nwg = nM * nN; G = G_; c = c_; }
    __host__ __device__ bool next(int i, Unit& u) const {
        const long L = (long)i * G + c; if (L >= nwg) return false;
        int wgid = (int)L; { const int q = nwg / NXCD, r = nwg % NXCD, xcd = wgid % NXCD, off = wgid / NXCD; wgid = (xcd < r ? xcd * (q + 1) : r * (q + 1) + (xcd - r) * q) + off; }
        const int nig = WGM * nN, gid = wgid / nig, fm = gid * WGM, gsz = (nM - fm) < WGM ? (nM - fm) : WGM;
        u.pm = fm + ((wgid % nig) % gsz); u.pn = (wgid % nig) / gsz; return true;
    }
    __device__ __forceinline__ void a_ready(const Unit&) const {}
    __device__ __forceinline__ void done(const Unit&) const {}
};

__device__ __forceinline__ unsigned cvt_pk_bf16(float lo, float hi) { unsigned r; asm volatile("v_cvt_pk_bf16_f32 %0, %1, %2" : "=v"(r) : "v"(lo), "v"(hi)); return r; }
typedef float f32x2 __attribute__((ext_vector_type(2)));
__device__ __forceinline__ f32x2 gelu_pk(f32x2 v) {
    const f32x2 av = __builtin_elementwise_abs(v), d = av * 0.2316418882f + 1.0f;
    f32x2 t; t.x = __builtin_amdgcn_rcpf(d.x); t.y = __builtin_amdgcn_rcpf(d.y);
    f32x2 q = t * 0.5307027145f + (-0.7265760135f); q = q * t + 0.7107068705f; q = q * t + (-0.142248368f); q = q * t + 0.127414796f; q = q * t;
    const f32x2 s = (v * v) * (-0.72134752044f);
    f32x2 e; e.x = __builtin_amdgcn_exp2f(s.x); e.y = __builtin_amdgcn_exp2f(s.y);
    const f32x2 m = v * (q * e), r = v - m;
    f32x2 o; o.x = v.x < 0.f ? m.x : r.x; o.y = v.y < 0.f ? m.y : r.y; return o;
}

template <int ACT  > struct EpiBf16 {
    static constexpr bool PERM = true, AFTER_DRAIN = false; static_assert(ACT == 0 || ACT == 1, "EpiBf16: ACT is 0 (none) or 1 (gelu_pk)");
    bf16_t* O; int ldc; const float* bias; int split_cols; size_t split_stride; float scale0;
    __device__ __forceinline__ void operator()(const f32x4 (&acc)[2][2][4][2], const Unit& u, int wr, int wc, int fr, int fq) const {
        const int row0 = u.pm * BM + wr * 64 + fr; int colt = u.pn * BM; bf16_t* base = O;
        float sc = 1.f; if (split_cols) { const int t = colt / split_cols; base += (size_t)t * split_stride; colt -= t * split_cols; if (t == 0) sc = scale0; }
        const int col0 = colt + wc * 32 + 8 * fq, bcol0 = u.pn * BM + wc * 32 + 8 * fq;
        f32x4 bv[2][2];
#pragma unroll
        for (int bj = 0; bj < 2; ++bj)
#pragma unroll
            for (int n = 0; n < 2; ++n) bv[bj][n] = bias ? *(const f32x4*)(bias + bcol0 + bj * HALF + 4 * n) : (f32x4){0.f, 0.f, 0.f, 0.f};
#pragma unroll
        for (int ai = 0; ai < 2; ++ai)
#pragma unroll
            for (int m = 0; m < 4; ++m) { bf16_t* rowp = base + (size_t)(row0 + ai * HALF + m * 16) * ldc + col0;
#pragma unroll
                for (int bj = 0; bj < 2; ++bj) { f32x4 v0 = acc[ai][bj][m][0] + bv[bj][0], v1 = acc[ai][bj][m][1] + bv[bj][1];
                    if (ACT == 1) { f32x2 a = gelu_pk((f32x2){v0[0], v0[1]}), b = gelu_pk((f32x2){v0[2], v0[3]}), c = gelu_pk((f32x2){v1[0], v1[1]}), d = gelu_pk((f32x2){v1[2], v1[3]});
                        v0 = (f32x4){a.x, a.y, b.x, b.y}; v1 = (f32x4){c.x, c.y, d.x, d.y}; }
                    v0 = v0 * sc; v1 = v1 * sc; u32x4 w; w.x = cvt_pk_bf16(v0[0], v0[1]); w.y = cvt_pk_bf16(v0[2], v0[3]); w.z = cvt_pk_bf16(v1[0], v1[1]); w.w = cvt_pk_bf16(v1[2], v1[3]);
                    *(u32x4*)(rowp + bj * HALF) = w; } }
    }
};
struct EpiSwiGLU {
    static constexpr bool PERM = true, AFTER_DRAIN = false;
    bf16_t* O; int ldc;
    __device__ __forceinline__ void operator()(const f32x4 (&acc)[2][2][4][2], const Unit& u, int wr, int wc, int fr, int fq) const {
        const int row0 = u.pm * BM + wr * 64 + fr; const int col0 = u.pn * HALF + wc * 32 + 8 * fq;
#pragma unroll
        for (int ai = 0; ai < 2; ++ai)
#pragma unroll
            for (int m = 0; m < 4; ++m) { bf16_t* rowp = O + (size_t)(row0 + ai * HALF + m * 16) * ldc + col0;
                float r[8];
#pragma unroll
                for (int n = 0; n < 2; ++n)
#pragma unroll
                    for (int j = 0; j < 4; ++j) { const float g = acc[ai][0][m][n][j], up = acc[ai][1][m][n][j];
                        const float e = __builtin_amdgcn_exp2f(g * -1.4426950408889634f); r[n * 4 + j] = g * __builtin_amdgcn_rcpf(1.0f + e) * up; }
                u32x4 w; w.x = cvt_pk_bf16(r[0], r[1]); w.y = cvt_pk_bf16(r[2], r[3]); w.z = cvt_pk_bf16(r[4], r[5]); w.w = cvt_pk_bf16(r[6], r[7]);
                *(u32x4*)rowp = w; }
    }
};

struct EpiQKU {
    static constexpr bool PERM = true, AFTER_DRAIN = false;
    bf16_t* S0; float qscale;
    __device__ __forceinline__ void operator()(const f32x4 (&acc)[2][2][4][2], const Unit& u, int wr, int wc, int fr, int fq) const {
        const int sec = u.pn >> 1, cbase = (u.pn & 1) * BM + wc * 32 + 8 * fq; const float sc = sec == 0 ? qscale : 1.0f;
#pragma unroll
        for (int ai = 0; ai < 2; ++ai)
#pragma unroll
            for (int m = 0; m < 4; ++m) { const int tok = u.pm * BM + ai * HALF + wr * 64 + m * 16 + fr, b = tok >> 11, s = tok & 2047, tile = s >> 5, key = s & 31;
                const int slot = sec == 0 ? key : ((key & ~12) | ((key & 4) << 1) | ((key & 8) >> 1));
#pragma unroll
                for (int bj = 0; bj < 2; ++bj) { const int c = cbase + bj * HALF, h = c >> 6, d = c & 63;
                    bf16_t* sb = S0 + (size_t)(b >> 1) * ((size_t)4096 * 2816) + (size_t)(b & 1) * ((size_t)1 << 20) + (size_t)sec * ((size_t)2 << 20);
                    bf16_t* p = sec == 2 ? sb + (size_t)s * 512 + c
                                         : sb + (((size_t)h * 64 + tile) * 4 + (d >> 4)) * 512 + ((d >> 3) & 1) * 256 + slot * 8;
                    const f32x4 v0 = acc[ai][bj][m][0] * sc, v1 = acc[ai][bj][m][1] * sc;
                    u32x4 w; w.x = cvt_pk_bf16(v0[0], v0[1]); w.y = cvt_pk_bf16(v0[2], v0[3]); w.z = cvt_pk_bf16(v1[0], v1[1]); w.w = cvt_pk_bf16(v1[2], v1[3]);
                    *(u32x4*)p = w; } }
    }
};

struct EpiVT {
    static constexpr bool PERM = true, AFTER_DRAIN = false;
    bf16_t* O;
    __device__ __forceinline__ void operator()(const f32x4 (&acc)[2][2][4][2], const Unit& u, int wr, int wc, int fr, int fq) const {
        const int row0 = u.pm * BM + wr * 64 + fr, col0 = u.pn * BM + wc * 32 + 8 * fq;
#pragma unroll
        for (int ai = 0; ai < 2; ++ai)
#pragma unroll
            for (int m = 0; m < 4; ++m) { const int c = row0 + ai * HALF + m * 16, h = c >> 6, d = c & 63;
#pragma unroll
                for (int bj = 0; bj < 2; ++bj) { const int tok = col0 + bj * HALF, b = tok >> 11, s = tok & 2047;
                    bf16_t* p = O + (size_t)(b >> 1) * ((size_t)4096 * 2816) + (size_t)(b & 1) * ((size_t)1 << 20) + ((size_t)6 << 20) + ((size_t)h * 64 + (s >> 5)) * 2048 + (((d >> 5) * 2 + ((s >> 4) & 1)) * 2 + ((s >> 3) & 1)) * 256 + (d & 31) * 8;
                    const f32x4 v0 = acc[ai][bj][m][0], v1 = acc[ai][bj][m][1];
                    u32x4 w; w.x = cvt_pk_bf16(v0[0], v0[1]); w.y = cvt_pk_bf16(v0[2], v0[3]); w.z = cvt_pk_bf16(v1[0], v1[1]); w.w = cvt_pk_bf16(v1[2], v1[3]);
                    *(u32x4*)p = w; } }
    }
};

template <class Epi, class Sched, bool ALIGN_EPI = false, bool SP2 = false>
__device__ __forceinline__ void gemm_phase(PG8_LAS unsigned char* lds, const Gemm g, const Sched& S, const Epi& E) {
    const int tid = threadIdx.x, wid = __builtin_amdgcn_readfirstlane(tid >> 6), lane = tid & 63, wr = wid >> 2, wc = wid & 3, fr = lane & 15, fq = lane >> 4;
    const int K = g.K, nt = K / BK;
    unsigned voffA[2], voffB[2];
#pragma unroll
    for (int i = 0; i < 2; ++i) { int R, C; stage_rc(tid * 16 + i * 8192, R, C); const int Rb = Epi::PERM ? ((R & ~31) + perm32(R & 31)) : R;
        voffA[i] = (unsigned)(R * K + C) * 2u; voffB[i] = (unsigned)(Rb * K + C) * 2u; }
    const size_t kstep = (size_t)(BK * 2);
    const size_t hstep = (size_t)HALF * K * 2;
    const size_t tstep = 2 * hstep;
    const unsigned ldsw = (unsigned)wid * 1024u;
    const int aoff = lds_byte(wr * 64 + fr, fq * 8), boff = lds_byte(wc * 32 + fr, fq * 8);
#define PG8_SA(b, h) (((b) * 2 + (h)) * HTB)
#define PG8_SB(b, h) ((4 + (b) * 2 + (h)) * HTB)
#define PG8_STAGE(bufoff, gbase, voff) do { _Pragma("unroll") for (int _i = 0; _i < 2; ++_i) \
        __builtin_amdgcn_global_load_lds((const unsigned*)((const char*)(gbase) + (voff)[_i]), (PG8_LAS unsigned*)(lds + (bufoff) + ldsw + _i * 8192), 16, 0, 0); } while (0)
#define PG8_LDA(dst, b, h) do { _Pragma("unroll") for (int m = 0; m < 4; ++m) _Pragma("unroll") for (int k = 0; k < 2; ++k) dst[m][k] = *(const PG8_LAS bf16x8*)(lds + PG8_SA(b, h) + aoff + m * 2048 + k * 1024); } while (0)
#define PG8_LDB(dst, b, h) do { _Pragma("unroll") for (int n = 0; n < 2; ++n) _Pragma("unroll") for (int k = 0; k < 2; ++k) dst[n][k] = *(const PG8_LAS bf16x8*)(lds + PG8_SB(b, h) + boff + n * 2048 + k * 1024); } while (0)
#define PG8_MMA(ai, bj, At, Bt) do { __builtin_amdgcn_s_setprio(1); _Pragma("unroll") for (int m = 0; m < 4; ++m) _Pragma("unroll") for (int n = 0; n < 2; ++n) _Pragma("unroll") for (int k = 0; k < 2; ++k) \
        acc[ai][bj][m][n] = __builtin_amdgcn_mfma_f32_16x16x32_bf16(Bt[n][k], At[m][k], acc[ai][bj][m][n], 0, 0, 0); __builtin_amdgcn_s_setprio(0); } while (0)
#define PG8_WAIT_V(n) asm volatile("s_waitcnt vmcnt(" #n ")" ::: "memory")
#define PG8_WAIT_L(n) asm volatile("s_waitcnt lgkmcnt(" #n ")" ::: "memory")
#define PG8_BAR __builtin_amdgcn_s_barrier()
#define PG8_SCHED __builtin_amdgcn_sched_barrier(0)
    Unit cur, nxt; int ui = 0;
    if (!S.next(0, cur)) return;
    f32x4 acc[2][2][4][2];
#pragma unroll
    for (int a = 0; a < 2; ++a)
#pragma unroll
        for (int b = 0; b < 2; ++b)
#pragma unroll
            for (int m = 0; m < 4; ++m)
#pragma unroll
                for (int n = 0; n < 2; ++n) acc[a][b][m][n] = (f32x4){0.f, 0.f, 0.f, 0.f};
    bf16x8 At[4][2], B0[2][2], B1[2][2];
    const char* cA = (const char*)g.A + (size_t)cur.pm * tstep; const char* cB = (const char*)g.Bt + (size_t)cur.pn * tstep;
    S.a_ready(cur);
    if constexpr (SP2) {
        PG8_STAGE(PG8_SB(0, 0), cB, voffB); PG8_STAGE(PG8_SB(0, 1), cB + hstep, voffB); PG8_STAGE(PG8_SA(0, 0), cA, voffA); PG8_STAGE(PG8_SA(0, 1), cA + hstep, voffA);
        if (wr == 1) PG8_BAR;
        PG8_WAIT_V(2); PG8_BAR;
        PG8_STAGE(PG8_SB(1, 0), cB + kstep, voffB); PG8_STAGE(PG8_SA(1, 0), cA + kstep, voffA); PG8_STAGE(PG8_SB(1, 1), cB + hstep + kstep, voffB);
        PG8_WAIT_V(6); PG8_BAR;
    } else {
        PG8_STAGE(PG8_SB(0, 0), cB, voffB); PG8_STAGE(PG8_SA(0, 0), cA, voffA); PG8_STAGE(PG8_SB(0, 1), cB + hstep, voffB); PG8_STAGE(PG8_SA(0, 1), cA + hstep, voffA);
        if (wr == 1) PG8_BAR;
        PG8_WAIT_V(4); PG8_BAR;
        PG8_STAGE(PG8_SB(1, 0), cB + kstep, voffB); PG8_STAGE(PG8_SA(1, 0), cA + kstep, voffA); PG8_STAGE(PG8_SB(1, 1), cB + hstep + kstep, voffB);
        PG8_WAIT_V(6); PG8_BAR;
    }
    for (;;) {
        const bool has_next = S.next(ui + 1, nxt);
        const char* nA = has_next ? (const char*)g.A + (size_t)nxt.pm * tstep : cA; const char* nB = has_next ? (const char*)g.Bt + (size_t)nxt.pn * tstep : cB;
        for (int t = 0; t < nt; t += 2) {
            const bool last = (t == nt - 2);
            const char* a1 = cA + (size_t)(t + 1) * kstep;
            const char* a2 = last ? nA : cA + (size_t)(t + 2) * kstep; const char* b2 = last ? nB : cB + (size_t)(t + 2) * kstep;
            const char* a3 = a2 + kstep; const char* b3 = b2 + kstep;
            if (last && has_next) S.a_ready(nxt);
            if constexpr (SP2) {
            PG8_LDB(B0, 0, 0); PG8_LDB(B1, 0, 1); PG8_SCHED; PG8_LDA(At, 0, 0); PG8_STAGE(PG8_SA(1, 1), a1 + hstep, voffA);
            PG8_WAIT_V(8); PG8_WAIT_L(0); PG8_BAR; PG8_MMA(0, 0, At, B0); PG8_MMA(0, 1, At, B1); PG8_BAR; PG8_SCHED;
            PG8_LDA(At, 0, 1); PG8_STAGE(PG8_SB(0, 0), b2, voffB); PG8_STAGE(PG8_SB(0, 1), b2 + hstep, voffB); PG8_STAGE(PG8_SA(0, 0), a2, voffA);
            PG8_WAIT_V(8); PG8_WAIT_L(0); PG8_BAR; PG8_MMA(1, 0, At, B0); PG8_MMA(1, 1, At, B1); PG8_BAR; PG8_SCHED;
            PG8_LDB(B0, 1, 0); PG8_LDB(B1, 1, 1); PG8_SCHED; PG8_LDA(At, 1, 0); PG8_STAGE(PG8_SA(0, 1), a2 + hstep, voffA);
            PG8_WAIT_V(8); PG8_WAIT_L(0); PG8_BAR; PG8_MMA(0, 0, At, B0); PG8_MMA(0, 1, At, B1); PG8_BAR; PG8_SCHED;
            PG8_LDA(At, 1, 1); PG8_STAGE(PG8_SB(1, 0), b3, voffB); PG8_STAGE(PG8_SB(1, 1), b3 + hstep, voffB); PG8_STAGE(PG8_SA(1, 0), a3, voffA);
            PG8_WAIT_V(8); PG8_WAIT_L(0); PG8_BAR; PG8_MMA(1, 0, At, B0); PG8_MMA(1, 1, At, B1); PG8_BAR; PG8_SCHED;
            } else {
            PG8_LDB(B0, 0, 0); PG8_SCHED; PG8_LDA(At, 0, 0); PG8_STAGE(PG8_SA(1, 1), a1 + hstep, voffA);
            PG8_WAIT_L(8); PG8_BAR; PG8_WAIT_L(0); PG8_MMA(0, 0, At, B0); PG8_BAR; PG8_SCHED;
            PG8_LDB(B1, 0, 1); PG8_STAGE(PG8_SB(0, 0), b2, voffB);
            PG8_BAR; PG8_WAIT_L(0); PG8_MMA(0, 1, At, B1); PG8_BAR;
            PG8_LDA(At, 0, 1); PG8_STAGE(PG8_SA(0, 0), a2, voffA);
            PG8_BAR; PG8_WAIT_L(0); PG8_MMA(1, 0, At, B0); PG8_BAR; PG8_SCHED;
            PG8_STAGE(PG8_SB(0, 1), b2 + hstep, voffB);
            PG8_WAIT_V(6); PG8_BAR; PG8_MMA(1, 1, At, B1); PG8_BAR;
            PG8_LDB(B0, 1, 0); PG8_SCHED; PG8_LDA(At, 1, 0); PG8_STAGE(PG8_SA(0, 1), a2 + hstep, voffA);
            PG8_WAIT_L(8); PG8_BAR; PG8_WAIT_L(0); PG8_MMA(0, 0, At, B0); PG8_BAR; PG8_SCHED;
            PG8_LDB(B1, 1, 1); PG8_STAGE(PG8_SB(1, 0), b3, voffB);
            PG8_BAR; PG8_WAIT_L(0); PG8_MMA(0, 1, At, B1); PG8_BAR;
            PG8_LDA(At, 1, 1); PG8_STAGE(PG8_SA(1, 0), a3, voffA);
            PG8_BAR; PG8_WAIT_L(0); PG8_MMA(1, 0, At, B0); PG8_BAR; PG8_SCHED;
            PG8_STAGE(PG8_SB(1, 1), b3 + hstep, voffB);
            PG8_WAIT_V(6); PG8_BAR; PG8_MMA(1, 1, At, B1); PG8_BAR;
            }
        }
        if constexpr (ALIGN_EPI) { if (wr == 0) PG8_BAR; }
        if constexpr (!Epi::AFTER_DRAIN) { E(acc, cur, wr, wc, fr, fq); S.done(cur); }
        if (!has_next) break;
#pragma unroll
        for (int a = 0; a < 2; ++a)
#pragma unroll
            for (int b = 0; b < 2; ++b)
#pragma unroll
                for (int m = 0; m < 4; ++m)
#pragma unroll
                    for (int n = 0; n < 2; ++n) acc[a][b][m][n] = (f32x4){0.f, 0.f, 0.f, 0.f};
        cur = nxt; cA = nA; cB = nB; ++ui;
        if constexpr (ALIGN_EPI) { if (wr == 1) PG8_BAR; }
    }
    PG8_WAIT_V(0);
    if constexpr (!ALIGN_EPI) { if (wr == 0) PG8_BAR; }
    PG8_BAR;
    if constexpr (Epi::AFTER_DRAIN) { E.fused(acc, cur, wr, wc, fr, fq, lds, wid, lane); S.done(cur); }
#undef PG8_SA
#undef PG8_SB
#undef PG8_STAGE
#undef PG8_LDA
#undef PG8_LDB
#undef PG8_MMA
#undef PG8_WAIT_V
#undef PG8_WAIT_L
#undef PG8_BAR
#undef PG8_SCHED
}
}

#ifndef PG8_SP2
#define PG8_SP2 true
#endif
#ifndef PG8_ALIGN
#define PG8_ALIGN true
#endif

constexpr int BATCH = 16, SEQ = 2048, D = 1024, M = BATCH * SEQ;
constexpr int NH = 8, HD = 64, SBW = 512, PW = 512, DFF = 2816, NMOD = 6;
constexpr int PROJ_LD = 1536;
constexpr float EPS = 1e-6f;
constexpr float C2 = 0.125f * 1.4426950408889634f;
constexpr int NWAVES = 8;
#ifndef DUP
#define DUP 0
#endif
constexpr size_t MiB = 1u << 20;
constexpr size_t WS_MOD = 0;
constexpr size_t WS_CTL = 512 * 1024, CTL_BYTES = 32768;
constexpr size_t WS_WIN = 1 * MiB;
constexpr size_t WS_WO = 5 * MiB;
constexpr size_t WS_WGU = 7 * MiB;
constexpr size_t WS_WD = 18 * MiB;
constexpr size_t WS_H = 24 * MiB;
constexpr size_t WS_MIX = 88 * MiB;
constexpr size_t WS_ACT = 152 * MiB;
constexpr size_t SLAB_E = (size_t)4096 * DFF;
constexpr size_t Q_OFF = 0, K_OFF = (size_t)2 << 20, U_OFF = (size_t)4 << 20, V_OFF = (size_t)6 << 20;
constexpr size_t WS_CAT = 328 * MiB;
constexpr size_t WS_X1 = 392 * MiB;
constexpr size_t WS_XB = 456 * MiB;
constexpr size_t WS_PART = 457 * MiB;
constexpr size_t WS_END = 464 * MiB;
static_assert(V_OFF + ((size_t)2 << 20) <= SLAB_E, "slab sections");
static_assert(WS_ACT + (size_t)M * DFF * 2 <= WS_END, "ws map");
constexpr int LDS_BYTES = 147456;

#define GAS __attribute__((address_space(1)))
#define LAS __attribute__((address_space(3)))
typedef unsigned short bf16;
typedef unsigned v4u __attribute__((ext_vector_type(4)));
typedef unsigned v2u __attribute__((ext_vector_type(2)));
typedef float f32x4 __attribute__((ext_vector_type(4)));
typedef float f32x16 __attribute__((ext_vector_type(16)));
typedef short bf16x8 __attribute__((ext_vector_type(8)));
typedef float f32x2_t __attribute__((ext_vector_type(2))); typedef __bf16 bf16x2_t __attribute__((ext_vector_type(2)));
__device__ __forceinline__ unsigned pk2(float lo, float hi) { f32x2_t v = {lo, hi}; bf16x2_t b = __builtin_convertvector(v, bf16x2_t); return __builtin_bit_cast(unsigned, b); }
__device__ __forceinline__ float bf_lo(unsigned w) { return __uint_as_float(w << 16); }
__device__ __forceinline__ float bf_hi(unsigned w) { return __uint_as_float(w & 0xffff0000u); }
__device__ __forceinline__ float wave_sum(float v) {
#pragma unroll
    for (int o = 1; o < 64; o <<= 1) v += __shfl_xor(v, o);
    return v;
}

__host__ __device__ __forceinline__ size_t slab_off(int b) { return (size_t)(b >> 1) * SLAB_E + (size_t)(b & 1) * ((size_t)1 << 20); }

struct Params {
    const float *x, *c, *w_cond, *b_cond, *g_mix_pre, *g_mix_post, *w_in, *w_pool, *pool_scale, *w_out, *g_ffn_pre, *g_ffn_post, *w_gate, *w_up, *w_down;
    float* out; unsigned char* ws; int use_cg_sync; int pad;
};

__device__ __forceinline__ void transpose_item(const float* W, int ldw, bf16* WT, int ldt, int k0, int n0, int drow0, LAS float* scr, int lane) {
#pragma unroll
    for (int i = 0; i < 32; ++i) { const int kk = 2 * i + (lane >> 5); scr[kk * 33 + (lane & 31)] = __builtin_nontemporal_load(W + (size_t)(k0 + kk) * ldw + n0 + (lane & 31)); }
    asm volatile("s_waitcnt lgkmcnt(0)" ::: "memory");
    const int c = lane & 7;
#pragma unroll
    for (int j = 0; j < 4; ++j) { const int n = (lane >> 3) + 8 * j; const LAS float* s = scr + (8 * c) * 33 + n;
        v4u o; o.x = pk2(s[0 * 33], s[1 * 33]); o.y = pk2(s[2 * 33], s[3 * 33]); o.z = pk2(s[4 * 33], s[5 * 33]); o.w = pk2(s[6 * 33], s[7 * 33]);
        *(v4u*)(WT + (size_t)(drow0 + n) * ldt + k0 + 8 * c) = o; }
    asm volatile("s_waitcnt lgkmcnt(0)" ::: "memory");
}

__device__ __forceinline__ void p0_prologue(const Params& P, LAS unsigned char* lds, int tid, int lane, int wave, int mode = 3) {
    LAS float* sc = (LAS float*)lds;
    LAS float* red = (LAS float*)(lds + 4096);
    float* part = (float*)(P.ws + WS_PART);
    if (mode & 1) for (int item = blockIdx.x; item < 256; item += gridDim.x) {
        const int kc = item >> 4, cc = item & 15;
        for (int i = tid; i < 1024; i += NWAVES * 64) { const int b = i >> 6, kk = i & 63; const float v = P.c[b * D + 64 * kc + kk]; sc[kk * 16 + b] = v / (1.0f + __expf(-v)); }
        __syncthreads();
        if (tid < 480) {
            const int cg4 = tid % 96, ks = tid / 96;
            f32x4 acc[16];
#pragma unroll
            for (int b = 0; b < 16; ++b) acc[b] = (f32x4){0.f, 0.f, 0.f, 0.f};
            const float* wp = P.w_cond + (size_t)(64 * kc + ks) * (NMOD * D) + 384 * cc + 4 * cg4;
            f32x4 wv[13];
#pragma unroll
            for (int i = 0; i < 13; ++i) wv[i] = (ks + 5 * i < 64) ? __builtin_nontemporal_load((const f32x4*)(wp + (size_t)(5 * i) * (NMOD * D))) : (f32x4){0.f, 0.f, 0.f, 0.f};
#pragma unroll
            for (int i = 0; i < 13; ++i) { const int kk = (ks + 5 * i < 64) ? ks + 5 * i : 63; const LAS f32x4* s4 = (const LAS f32x4*)(sc + kk * 16);
#pragma unroll
                for (int q = 0; q < 4; ++q) { const f32x4 s = s4[q]; acc[4 * q + 0] += wv[i] * s[0]; acc[4 * q + 1] += wv[i] * s[1]; acc[4 * q + 2] += wv[i] * s[2]; acc[4 * q + 3] += wv[i] * s[3]; } }
#pragma unroll
            for (int b = 0; b < 16; ++b) *(LAS f32x4*)(red + (ks * 16 + b) * 384 + 4 * cg4) = acc[b];
        }
        __syncthreads();
        for (int idx = tid; idx < 16 * 384; idx += NWAVES * 64) { const int b = idx / 384, col = idx % 384; float s = 0.f;
#pragma unroll
            for (int ks = 0; ks < 5; ++ks) s += red[(ks * 16 + b) * 384 + col];
            part[((size_t)kc * 16 + b) * (NMOD * D) + 384 * cc + col] = s; }
        __syncthreads();
    }
    LAS float* scr = (LAS float*)(lds + wave * 16384);
    const int gw = blockIdx.x * NWAVES + wave, NGW = gridDim.x * NWAVES;
    bf16* WinT = (bf16*)(P.ws + WS_WIN); bf16* WoT = (bf16*)(P.ws + WS_WO); bf16* WguT = (bf16*)(P.ws + WS_WGU); bf16* WdT = (bf16*)(P.ws + WS_WD);
    constexpr int I_IN = 16 * 64, I_O = 8 * 32, I_G = 16 * 88, I_D = 44 * 32, I_E = 16 * 64;
    constexpr int NITEMS = I_IN + I_O + 2 * I_G + I_D + I_E;
    if (mode & 2) for (int it = gw; it < NITEMS; it += NGW) {
        int r = it;
        if (r < I_IN) { const int kb = r >> 6, nb = r & 63, n0 = nb * 32; const int sec = n0 >> 9;
            const int drow = (sec == 2) ? 1536 + (n0 - 1024) : (sec == 3) ? 1024 + (n0 - 1536) : n0;
            transpose_item(P.w_in, 2048, WinT, 1024, kb * 64, n0, drow, scr, lane); continue; } r -= I_IN;
        if (r < I_O) { const int kb = r >> 5, nb = r & 31; transpose_item(P.w_out, 1024, WoT, 1024, kb * 64, nb * 32, nb * 32, scr, lane); continue; } r -= I_O;
        if (r < I_G) { const int kb = r / 88, nb = r % 88, n0 = nb * 32; transpose_item(P.w_gate, DFF, WguT, 1024, kb * 64, n0, (n0 >> 7) * 256 + (n0 & 127), scr, lane); continue; } r -= I_G;
        if (r < I_G) { const int kb = r / 88, nb = r % 88, n0 = nb * 32; transpose_item(P.w_up, DFF, WguT, 1024, kb * 64, n0, (n0 >> 7) * 256 + 128 + (n0 & 127), scr, lane); continue; } r -= I_G;
        if (r < I_D) { const int kb = r >> 5, nb = r & 31; transpose_item(P.w_down, 1024, WdT, DFF, kb * 64, nb * 32, nb * 32, scr, lane); continue; } r -= I_D;
        {
            const int nb = r & 15, kc = r >> 4, g = kc >> 4, kl0 = (kc & 15) * 8, n = nb * 64 + lane;
            float acc[8];
#pragma unroll
            for (int i = 0; i < 8; ++i) acc[i] = 0.f;
            const float* wpp = P.w_pool + (size_t)g * 128 * 128 + (size_t)kl0 * 128;
            const float* wop = P.w_out + (size_t)(512 + g * 128) * 1024 + n;
            const float* psp = P.pool_scale + g * 128;
#pragma unroll 16
            for (int c = 0; c < 128; ++c) { const float wo = wop[(size_t)c * 1024] * psp[c];
#pragma unroll
                for (int i = 0; i < 8; ++i) acc[i] += wpp[i * 128 + c] * wo; }
            v4u o; o.x = pk2(acc[0], acc[1]); o.y = pk2(acc[2], acc[3]); o.z = pk2(acc[4], acc[5]); o.w = pk2(acc[6], acc[7]);
            *(v4u*)(WoT + (size_t)n * 1024 + 512 + g * 128 + kl0) = o;
        }
    }
}

__device__ __forceinline__ f32x4 unpack_bf4(v2u w) { return (f32x4){bf_lo(w.x), bf_hi(w.x), bf_lo(w.y), bf_hi(w.y)}; }
__device__ __forceinline__ float sumsq4(const f32x4 (&v)[4]) { float ss = 0.f;
#pragma unroll
    for (int j = 0; j < 4; ++j) ss += (v[j][0] * v[j][0] + v[j][1] * v[j][1]) + (v[j][2] * v[j][2] + v[j][3] * v[j][3]);
    return ss; }
constexpr int NPF = 3;
__device__ __forceinline__ void p1_rows(const Params& P, LAS unsigned char* lds, int tid, int lane, int wave, int vb) {
    const int gw = vb * NWAVES + wave, NGW = gridDim.x * NWAVES;
    float* mod = (float*)(P.ws + WS_MOD); bf16* H = (bf16*)(P.ws + WS_H); const float* part = (const float*)(P.ws + WS_PART);
    LAS float* ms = (LAS float*)lds;
    for (int ch = gw; ch < M / 16; ch += NGW) {
        const int r0 = ch * 16, b = r0 / SEQ;
        {
            const int sub = ((ch - wave) / NWAVES) & 15;
            float sv[5]; int cols[5];
#pragma unroll
            for (int j = 0; j < 5; ++j) { cols[j] = j < 4 ? tid + 512 * j : 2048 + 256 * sub + (tid & 255); sv[j] = P.b_cond[cols[j]]; }
#pragma unroll 4
            for (int kc = 0; kc < 16; ++kc) { const float* pp = part + ((size_t)kc * 16 + b) * (NMOD * D);
#pragma unroll
                for (int j = 0; j < 5; ++j) sv[j] += pp[cols[j]]; }
            __syncthreads();
#pragma unroll
            for (int j = 0; j < 4; ++j) ms[cols[j]] = sv[j];
            if (tid < 256) mod[(size_t)b * (NMOD * D) + cols[4]] = sv[4];
            __syncthreads();
        }
        const f32x4* xb = (const f32x4*)(P.x + (size_t)r0 * D) + lane;
        f32x4 ring[NPF + 1][4];
#pragma unroll
        for (int r = 0; r < NPF; ++r)
#pragma unroll
            for (int j = 0; j < 4; ++j) ring[r][j] = __builtin_nontemporal_load(xb + (size_t)r * (D / 4) + 64 * j);
        f32x4 a[4], sh[4];
#pragma unroll
        for (int j = 0; j < 4; ++j) { const int c0 = 4 * lane + 256 * j; const f32x4 g = *(const f32x4*)(P.g_mix_pre + c0), scl = *(const LAS f32x4*)(ms + D + c0); a[j] = g * (scl + 1.0f); sh[j] = *(const LAS f32x4*)(ms + c0); }
#pragma unroll 1
        for (int rb = 0; rb < 16; rb += NPF + 1)
#pragma unroll
        for (int rk = 0; rk < NPF + 1; ++rk) { const int r = rb + rk;
            if (r + NPF < 16) {
#pragma unroll
                for (int j = 0; j < 4; ++j) ring[(rk + NPF) % (NPF + 1)][j] = __builtin_nontemporal_load(xb + (size_t)(r + NPF) * (D / 4) + 64 * j); }
            const f32x4 (&v)[4] = ring[rk];
            const float rstd = 1.0f / sqrtf(wave_sum(sumsq4(v)) * (1.0f / D) + EPS);
            v2u* o8 = (v2u*)(H + (size_t)(r0 + r) * D) + lane;
#pragma unroll
            for (int j = 0; j < 4; ++j) { const f32x4 y = v[j] * rstd * a[j] + sh[j]; v2u w; w.x = pk2(y[0], y[1]); w.y = pk2(y[2], y[3]); o8[64 * j] = w; }
        }
    }
}
__device__ __forceinline__ void p5_rows(const Params& P, int lane, int wave, int vb) {
    const int gw = vb * NWAVES + wave, NGW = gridDim.x * NWAVES;
    const float* mod = (const float*)(P.ws + WS_MOD); bf16* H = (bf16*)(P.ws + WS_H); const bf16* MIX = (const bf16*)(P.ws + WS_MIX);
    for (int ch = gw; ch < M / 16; ch += NGW) {
        const int r0 = ch * 16, b = r0 / SEQ; const float* mb = mod + (size_t)b * (NMOD * D);
        const f32x4* xb = (const f32x4*)(P.x + (size_t)r0 * D) + lane; const v2u* mbp = (const v2u*)(MIX + (size_t)r0 * D) + lane;
        f32x4 rx[NPF + 1][4]; v2u rm[NPF + 1][4];
#pragma unroll
        for (int r = 0; r < NPF; ++r)
#pragma unroll
            for (int j = 0; j < 4; ++j) { rm[r][j] = __builtin_nontemporal_load(mbp + (size_t)r * (D / 4) + 64 * j); rx[r][j] = __builtin_nontemporal_load(xb + (size_t)r * (D / 4) + 64 * j); }
        f32x4 gm[4], a[4], sh[4];
#pragma unroll
        for (int j = 0; j < 4; ++j) { const int c0 = 4 * lane + 256 * j;
            gm[j] = *(const f32x4*)(mb + 2 * D + c0) * *(const f32x4*)(P.g_mix_post + c0);
            a[j] = *(const f32x4*)(P.g_ffn_pre + c0) * (*(const f32x4*)(mb + 4 * D + c0) + 1.0f); sh[j] = *(const f32x4*)(mb + 3 * D + c0); }
#pragma unroll 1
        for (int rb = 0; rb < 16; rb += NPF + 1)
#pragma unroll
        for (int rk = 0; rk < NPF + 1; ++rk) { const int r = rb + rk;
            if (r + NPF < 16) {
#pragma unroll
                for (int j = 0; j < 4; ++j) { rm[(rk + NPF) % (NPF + 1)][j] = __builtin_nontemporal_load(mbp + (size_t)(r + NPF) * (D / 4) + 64 * j); rx[(rk + NPF) % (NPF + 1)][j] = __builtin_nontemporal_load(xb + (size_t)(r + NPF) * (D / 4) + 64 * j); } }
            const size_t row = (size_t)(r0 + r);
            f32x4 mv[4], xv[4];
#pragma unroll
            for (int j = 0; j < 4; ++j) { mv[j] = unpack_bf4(rm[rk][j]); xv[j] = rx[rk][j]; }
            const float rstd = 1.0f / sqrtf(wave_sum(sumsq4(mv)) * (1.0f / D) + EPS);
#pragma unroll
            for (int j = 0; j < 4; ++j) xv[j] = xv[j] + gm[j] * (mv[j] * rstd);
            const float rstd2 = 1.0f / sqrtf(wave_sum(sumsq4(xv)) * (1.0f / D) + EPS);
            v2u* x8 = (v2u*)((bf16*)(P.ws + WS_X1) + row * D) + lane; v2u* o8 = (v2u*)(H + row * D) + lane;
#pragma unroll
            for (int j = 0; j < 4; ++j) { v2u xw; xw.x = pk2(xv[j][0], xv[j][1]); xw.y = pk2(xv[j][2], xv[j][3]); __builtin_nontemporal_store(xw, x8 + 64 * j);
                const f32x4 y = xv[j] * rstd2 * a[j] + sh[j]; v2u w; w.x = pk2(y[0], y[1]); w.y = pk2(y[2], y[3]); o8[64 * j] = w; }
        }
    }
}
__device__ __forceinline__ void p8_rows(const Params& P, int lane, int wave, int vb) {
    const int gw = vb * NWAVES + wave, NGW = gridDim.x * NWAVES;
    const float* mod = (const float*)(P.ws + WS_MOD); const bf16* FB = (const bf16*)(P.ws + WS_MIX); const bf16* X1 = (const bf16*)(P.ws + WS_X1);
    for (int ch = gw; ch < M / 16; ch += NGW) {
        const int r0 = ch * 16, b = r0 / SEQ; const float* mb = mod + (size_t)b * (NMOD * D);
        f32x4* ob = (f32x4*)(P.out + (size_t)r0 * D) + lane; const v2u* fbp = (const v2u*)(FB + (size_t)r0 * D) + lane; const v2u* xbp = (const v2u*)(X1 + (size_t)r0 * D) + lane;
        v2u rx[NPF + 1][4], rf[NPF + 1][4];
#pragma unroll
        for (int r = 0; r < NPF; ++r)
#pragma unroll
            for (int j = 0; j < 4; ++j) { rf[r][j] = __builtin_nontemporal_load(fbp + (size_t)r * (D / 4) + 64 * j); rx[r][j] = __builtin_nontemporal_load(xbp + (size_t)r * (D / 4) + 64 * j); }
        f32x4 gf[4];
#pragma unroll
        for (int j = 0; j < 4; ++j) { const int c0 = 4 * lane + 256 * j; gf[j] = *(const f32x4*)(mb + 5 * D + c0) * *(const f32x4*)(P.g_ffn_post + c0); }
#pragma unroll 1
        for (int rb = 0; rb < 16; rb += NPF + 1)
#pragma unroll
        for (int rk = 0; rk < NPF + 1; ++rk) { const int r = rb + rk;
            if (r + NPF < 16) {
#pragma unroll
                for (int j = 0; j < 4; ++j) { rf[(rk + NPF) % (NPF + 1)][j] = __builtin_nontemporal_load(fbp + (size_t)(r + NPF) * (D / 4) + 64 * j); rx[(rk + NPF) % (NPF + 1)][j] = __builtin_nontemporal_load(xbp + (size_t)(r + NPF) * (D / 4) + 64 * j); } }
            f32x4 fv[4];
#pragma unroll
            for (int j = 0; j < 4; ++j) fv[j] = unpack_bf4(rf[rk][j]);
            const float rstd = 1.0f / sqrtf(wave_sum(sumsq4(fv)) * (1.0f / D) + EPS);
#pragma unroll
            for (int j = 0; j < 4; ++j) __builtin_nontemporal_store(unpack_bf4(rx[rk][j]) + gf[j] * (fv[j] * rstd), ob + (size_t)r * (D / 4) + 64 * j);
        }
    }
}

template <int VAR> __device__ __forceinline__ void attn_unit(const bf16* PROJ, const bf16* VT, bf16* CAT, int b, int h, int qb, int lane) {
    const int r32 = lane & 31, hi = lane >> 5, t0 = qb * 32;
    const bf16* Qp = PROJ + slab_off(b) + Q_OFF + ((size_t)h * 64 + qb) * 2048 + lane * 8;
    bf16x8 qf[4];
#pragma unroll
    for (int d0 = 0; d0 < 4; ++d0) qf[d0] = *(const bf16x8*)(Qp + d0 * 512);
    const bf16* Kp = PROJ + slab_off(b) + K_OFF + (size_t)h * (SEQ * HD) + lane * 8;
    const bf16* Vp = VT + slab_off(b) + V_OFF + (size_t)h * (SEQ * HD) + lane * 8;
    f32x16 o0 = {}, o1 = {};
    float qc = 1.0f;
    bf16x8 ka[4], va[4], kb[4], vb[4], kc[4], vc[4];
#define LOADK(KF, jt) do { const int jt_ = (jt) > 0 ? (jt) : 0; const bf16* kp_ = Kp + jt_ * 2048; \
        _Pragma("unroll") for (int d0 = 0; d0 < 4; ++d0) KF[d0] = *(const bf16x8*)(kp_ + d0 * 512); } while (0)
#define LOADV(VF, jt) do { const int jt_ = (jt) > 0 ? (jt) : 0; const bf16* vp_ = Vp + jt_ * 2048; \
        VF[0] = *(const bf16x8*)(vp_); VF[1] = *(const bf16x8*)(vp_ + 512); VF[2] = *(const bf16x8*)(vp_ + 1024); VF[3] = *(const bf16x8*)(vp_ + 1536); } while (0)
#define TILE(KF, VF, jt, DIAG) do { \
        f32x16 s = {}; \
        _Pragma("unroll") for (int d0 = 0; d0 < 4; ++d0) s = __builtin_amdgcn_mfma_f32_32x32x16_bf16(KF[d0], qf[d0], s, 0, 0, 0); \
        LOADK(KF, (jt) - 3); \
        float e[16], dd[16]; \
        _Pragma("unroll") for (int r = 0; r < 16; ++r) { e[r] = __builtin_amdgcn_exp2f(__builtin_fminf(s[r], 120.0f)); dd[r] = 1.0f + e[r]; }     \
        if (DIAG) {                                                            \
            _Pragma("unroll") for (int r = 0; r < 16; ++r) { const int kk = 8 * hi + (r & 7) + 16 * (r >> 3); if (kk >= r32) { e[r] = 0.0f; dd[r] = 1.0f; } } } \
        const float G0 = ((dd[0] * dd[1]) * (dd[2] * dd[3])) * ((dd[4] * dd[5]) * (dd[6] * dd[7])); \
        const float G1 = ((dd[8] * dd[9]) * (dd[10] * dd[11])) * ((dd[12] * dd[13]) * (dd[14] * dd[15])); \
        const auto x0 = __builtin_amdgcn_permlane32_swap(__float_as_uint(G0), __float_as_uint(G0), false, false);     \
        const auto x1 = __builtin_amdgcn_permlane32_swap(__float_as_uint(G1), __float_as_uint(G1), false, false); \
        const float T0 = __uint_as_float(x0[0]) * __uint_as_float(x0[1]), T1 = __uint_as_float(x1[0]) * __uint_as_float(x1[1]); \
          \
        float r1 = __builtin_amdgcn_rcpf(qc * (hi ? 1.0f : __uint_as_float(x1[1])) * G1); \
        float r0 = __builtin_amdgcn_rcpf(qc * T1 * (hi ? 1.0f : __uint_as_float(x0[1])) * G0); \
        float w[16]; \
        _Pragma("unroll") for (int r = 0; r < 8; ++r) { w[r] = e[r] * r0; r0 *= dd[r]; w[8 + r] = e[8 + r] * r1; r1 *= dd[8 + r]; } \
        qc *= T0 * T1; \
        v4u pa0, pa1; \
        pa0.x = pk2(w[0], w[1]); pa0.y = pk2(w[2], w[3]); pa0.z = pk2(w[4], w[5]); pa0.w = pk2(w[6], w[7]); \
        pa1.x = pk2(w[8], w[9]); pa1.y = pk2(w[10], w[11]); pa1.z = pk2(w[12], w[13]); pa1.w = pk2(w[14], w[15]); \
        const bf16x8 P0 = __builtin_bit_cast(bf16x8, pa0), P1 = __builtin_bit_cast(bf16x8, pa1); \
        o0 = __builtin_amdgcn_mfma_f32_32x32x16_bf16(VF[0], P0, o0, 0, 0, 0); \
        o1 = __builtin_amdgcn_mfma_f32_32x32x16_bf16(VF[2], P0, o1, 0, 0, 0); \
        o0 = __builtin_amdgcn_mfma_f32_32x32x16_bf16(VF[1], P1, o0, 0, 0, 0); \
        o1 = __builtin_amdgcn_mfma_f32_32x32x16_bf16(VF[3], P1, o1, 0, 0, 0); \
        LOADV(VF, (jt) - 3); \
    } while (0)
#define DONE(jt) ((jt) == 0 || __ballot(qc <= 8.507059e37f) == 0ull)
    LOADK(ka, qb); LOADV(va, qb); LOADK(kb, qb - 1); LOADV(vb, qb - 1); LOADK(kc, qb - 2); LOADV(vc, qb - 2);
    TILE(ka, va, qb, true);
    if (!DONE(qb)) {
        int j = qb - 1;
        for (;;) {
            TILE(kb, vb, j, false); if (DONE(j)) break; --j;
            TILE(kc, vc, j, false); if (DONE(j)) break; --j;
            TILE(ka, va, j, false); if (DONE(j)) break; --j;
        }
    }
#undef LOADK
#undef LOADV
#undef TILE
#undef DONE
    bf16* Op = CAT + (size_t)(b * SEQ + t0 + r32) * D + h * HD + 4 * hi;
#pragma unroll
    for (int g = 0; g < 4; ++g) {
        v2u w0, w1; w0.x = pk2(o0[4 * g], o0[4 * g + 1]); w0.y = pk2(o0[4 * g + 2], o0[4 * g + 3]); w1.x = pk2(o1[4 * g], o1[4 * g + 1]); w1.y = pk2(o1[4 * g + 2], o1[4 * g + 3]);
        *(v2u*)(Op + 8 * g) = w0; *(v2u*)(Op + 32 + 8 * g) = w1; }
}
__device__ __forceinline__ void p3_mixers(const Params& P, LAS unsigned char* lds, int tid, int lane, int wave, int vb, int mode = 3) {
    const bf16* PROJ = (const bf16*)(P.ws + WS_ACT); const bf16* VT = PROJ; bf16* CAT = (bf16*)(P.ws + WS_CAT);
    const int gw = vb * NWAVES + wave, NGW = gridDim.x * NWAVES;
    constexpr int NQB = SEQ / 32, NUNITS = BATCH * NH * NQB;
    if (mode & 1) {
        LAS unsigned* qctr = (LAS unsigned*)(lds + 131072 + 1024) + ((mode >> 4) & 1);
        bf16* dst = (mode & 16) ? (bf16*)(P.ws + WS_END) : CAT;
        const unsigned per_wg = (unsigned)(NUNITS / (int)gridDim.x);
        for (;;) {
            unsigned i = 0; if (lane == 0) i = __hip_atomic_fetch_add(qctr, 1u, __ATOMIC_RELAXED, __HIP_MEMORY_SCOPE_WORKGROUP);
            i = (unsigned)__builtin_amdgcn_readfirstlane((int)i);
            if (i >= per_wg) break;
            const int lu = (int)(i >> 3) * 256 + (vb & 31) * NWAVES + (int)(i & 7), qb = lu & (NQB - 1), bhl = lu >> 6;
            attn_unit<0>(PROJ, VT, dst, 2 * (vb >> 5) + (bhl >> 3), bhl & 7, qb, lane);
        }
    }
    if (mode & 2) for (int wi = gw; wi < M / 16; wi += NGW) {
        const int m0 = wi * 16, sq0 = m0 & (SEQ - 1), g = lane >> 4, win = 2 << g;
        const bf16* up = PROJ + slab_off(m0 >> 11) + U_OFF + (size_t)sq0 * PW + lane * 8;
        float acc[8];
#pragma unroll
        for (int i = 0; i < 8; ++i) acc[i] = 0.f;
#pragma unroll
        for (int i = 1; i < 16; ++i) { const bool valid = (i < win) && (sq0 - i >= 0); const v4u w = *(const v4u*)(up - (ptrdiff_t)(valid ? i : 0) * PW); const float f = valid ? 1.0f : 0.0f;
            acc[0] += f * bf_lo(w.x); acc[1] += f * bf_hi(w.x); acc[2] += f * bf_lo(w.y); acc[3] += f * bf_hi(w.y); acc[4] += f * bf_lo(w.z); acc[5] += f * bf_hi(w.z); acc[6] += f * bf_lo(w.w); acc[7] += f * bf_hi(w.w); }
#pragma unroll 4
        for (int r = 0; r < 16; ++r) {
            const int sq = sq0 + r, ob = sq - (win - 1); const bool valid = ob >= 0;
            const v4u cur = *(const v4u*)(up + (size_t)r * PW);
            const v4u old = *(const v4u*)(up + (ptrdiff_t)(valid ? r - (win - 1) : r) * PW); const float f = valid ? 1.0f : 0.0f;
            const float c0 = bf_lo(cur.x), c1 = bf_hi(cur.x), c2 = bf_lo(cur.y), c3 = bf_hi(cur.y), c4 = bf_lo(cur.z), c5 = bf_hi(cur.z), c6 = bf_lo(cur.w), c7 = bf_hi(cur.w);
            acc[0] += c0; acc[1] += c1; acc[2] += c2; acc[3] += c3; acc[4] += c4; acc[5] += c5; acc[6] += c6; acc[7] += c7;
            const float inv = 1.0f / (float)((sq + 1 < win) ? sq + 1 : win);
            v4u o; o.x = pk2(acc[0] * inv - c0, acc[1] * inv - c1); o.y = pk2(acc[2] * inv - c2, acc[3] * inv - c3); o.z = pk2(acc[4] * inv - c4, acc[5] * inv - c5); o.w = pk2(acc[6] * inv - c6, acc[7] * inv - c7);
            *(v4u*)(CAT + (size_t)(m0 + r) * D + SBW + lane * 8) = o;
            acc[0] -= f * bf_lo(old.x); acc[1] -= f * bf_hi(old.x); acc[2] -= f * bf_lo(old.y); acc[3] -= f * bf_hi(old.y); acc[4] -= f * bf_lo(old.z); acc[5] -= f * bf_hi(old.z); acc[6] -= f * bf_lo(old.w); acc[7] -= f * bf_hi(old.w);
        }
    }
}

typedef GAS unsigned gu32;
#define XB_TMO      128
#define XB_XCNT(j)  (256  + 64 * (j))
#define XB_XSUB(j)  (1280 + 64 * (j))
#define XB_XGEN(j)  (2304 + 64 * (j))
#define XB_TOP      3328
#define XB_TOPGEN   3392
#define XCD_BAR_WORDS 3456
#define XB_SPIN_CAP (1u << 18)

__device__ __forceinline__ unsigned xb_ld(unsigned* p)              { return __hip_atomic_load(p, __ATOMIC_RELAXED, __HIP_MEMORY_SCOPE_AGENT); }
__device__ __forceinline__ unsigned xb_add(unsigned* p, unsigned v) { return __hip_atomic_fetch_add(p, v, __ATOMIC_RELAXED, __HIP_MEMORY_SCOPE_AGENT); }
__device__ __forceinline__ unsigned xb_xcc_id() { return (unsigned)__builtin_amdgcn_s_getreg((3 << 11) | 20) & 0xFu; }
#define XB_SPIN(cond, bar) do { unsigned _sp = 0; while (cond) { __builtin_amdgcn_s_sleep(1); \
    if ((++_sp & 255u) == 0u) { if (xb_ld(&(bar)[XB_TMO])) break; if (_sp > XB_SPIN_CAP) { atomicAdd(&(bar)[XB_TMO], 1u); break; } } } } while (0)

struct XcdBarrier {
    unsigned* bar; unsigned x;
    volatile LAS unsigned* st;
};

__device__ __forceinline__ XcdBarrier xcd_barrier_post(unsigned* bar, volatile LAS unsigned* st) {
    XcdBarrier b; b.bar = bar; b.x = xb_xcc_id(); b.st = st;
    if (threadIdx.x == 0) (void)xb_add(&bar[XB_XCNT(b.x)], 1u);
    return b;
}
__device__ __forceinline__ void xcd_barrier_complete(unsigned* bar, unsigned x, unsigned& nloc, unsigned& nx) {
    const unsigned G = gridDim.x * gridDim.y * gridDim.z;
    unsigned sum, cnt, mine, sp = 0u;
    for (;;) {
        sum = 0u; cnt = 0u; mine = 0u;
#pragma unroll
        for (unsigned j = 0; j < 16; ++j) { const unsigned c = xb_ld(&bar[XB_XCNT(j)]); sum += c; cnt += (c > 0u) ? 1u : 0u; mine = (j == x) ? c : mine; }
        if (sum == G) break;
        __builtin_amdgcn_s_sleep(1);
        if ((++sp & 255u) == 0u) { if (xb_ld(&bar[XB_TMO])) break; if (sp > XB_SPIN_CAP) { atomicAdd(&bar[XB_TMO], 1u); break; } }
    }
    nloc = mine > 0u ? mine : 1u; nx = cnt > 0u ? cnt : 1u;
}

__device__ __forceinline__ void xcd_barrier(const XcdBarrier& b) {
    asm volatile("s_waitcnt vmcnt(0)" ::: "memory");
    __syncthreads();
    if (threadIdx.x == 0) {
        unsigned* bar = b.bar;
        __builtin_amdgcn_s_waitcnt(0);
        unsigned nloc = b.st[0], nx = b.st[1];
        if (nloc == 0u) { xcd_barrier_complete(bar, b.x, nloc, nx); b.st[0] = nloc; b.st[1] = nx; }
        const unsigned old = xb_add(&bar[XB_XSUB(b.x)], 1u);
        const unsigned gen = old / nloc;
        if (old + 1u == (gen + 1u) * nloc) {
            __builtin_amdgcn_fence(__ATOMIC_RELEASE, "agent");
            asm volatile("s_waitcnt vmcnt(0)" ::: "memory");
            const unsigned og = xb_add(&bar[XB_TOP], 1u);
            const unsigned tg = og / nx;
            if (og + 1u == (tg + 1u) * nx) xb_add(&bar[XB_TOPGEN], 1u);
            else XB_SPIN(xb_ld(&bar[XB_TOPGEN]) == tg, bar);
            __builtin_amdgcn_fence(__ATOMIC_ACQUIRE, "agent");
            xb_add(&bar[XB_XGEN(b.x)], 1u);
            asm volatile("s_waitcnt vmcnt(0)" ::: "memory");
        } else {
            XB_SPIN(xb_ld(&bar[XB_XGEN(b.x)]) == gen, bar);
            __builtin_amdgcn_fence(__ATOMIC_ACQUIRE, "agent");
            asm volatile("s_waitcnt vmcnt(0)" ::: "memory");
        }
    }
    __syncthreads();
}

__device__ __forceinline__ void xcd_local_barrier(unsigned* ctl, unsigned x) {
    asm volatile("s_waitcnt vmcnt(0)" ::: "memory");
    __syncthreads();
    if (threadIdx.x == 0) {
        __builtin_amdgcn_s_waitcnt(0);
        const unsigned old = xb_add(&ctl[5120 + 64 * x], 1u), gen = old / 32u;
        if (old + 1u == (gen + 1u) * 32u) xb_add(&ctl[6144 + 64 * x], 1u);
        else XB_SPIN(xb_ld(&ctl[6144 + 64 * x]) == gen, ctl);
        __builtin_amdgcn_fence(__ATOMIC_ACQUIRE, "agent");
        asm volatile("s_waitcnt vmcnt(0)" ::: "memory");
    }
    __syncthreads();
}

__global__ void __launch_bounds__(NWAVES * 64, 2) hybrid_fwd(Params P) {
    extern __shared__ __attribute__((aligned(16))) unsigned char lds_raw[];
    cg::grid_group grid = cg::this_grid();
    LAS unsigned char* lds = (LAS unsigned char*)lds_raw;
    const int tid = threadIdx.x, lane = tid & 63, wave = __builtin_amdgcn_readfirstlane(tid >> 6);
    const int G = gridDim.x, bx = blockIdx.x;
    bf16* WinT = (bf16*)(P.ws + WS_WIN); bf16* WoT = (bf16*)(P.ws + WS_WO); bf16* WguT = (bf16*)(P.ws + WS_WGU); bf16* WdT = (bf16*)(P.ws + WS_WD);
    bf16* H = (bf16*)(P.ws + WS_H); bf16* MIX = (bf16*)(P.ws + WS_MIX); bf16* CAT = (bf16*)(P.ws + WS_CAT); bf16* ACT = (bf16*)(P.ws + WS_ACT);

    volatile LAS unsigned* bst = (volatile LAS unsigned*)(lds + 131072 + 512);
    if (tid < 2) bst[tid] = 0u;
    if (tid >= 64 && tid < 68) ((volatile LAS unsigned*)(lds + 131072 + 1024))[tid - 64] = 0u;
    __syncthreads();
    const XcdBarrier bar = xcd_barrier_post((unsigned*)(P.ws + WS_CTL), bst);
    if (P.use_cg_sync) grid.sync();
    unsigned* ctl = (unsigned*)(P.ws + WS_CTL);
    volatile LAS unsigned* vinfo = (volatile LAS unsigned*)(lds + 131072 + 1536);
    if (tid == 0) vinfo[0] = xb_add(&ctl[4096 + 64 * bar.x], 1u);
#define GRID_BAR() xcd_barrier(bar)
    p0_prologue(P, lds, tid, lane, wave);
    if (DUP == 1) { __syncthreads(); p0_prologue(P, lds, tid, lane, wave); }
    if (DUP == 11) { __syncthreads(); p0_prologue(P, lds, tid, lane, wave, 1); }
    if (DUP == 12) { __syncthreads(); p0_prologue(P, lds, tid, lane, wave, 2); }
    GRID_BAR();
    if (tid == 0) { bool ok = bar.x < 8u;
        for (unsigned j = 0; j < 16; ++j) ok = ok && (xb_ld(&ctl[XB_XCNT(j)]) == (j < 8u ? 32u : 0u));
        vinfo[1] = ok ? 1u : 0u; }
    __syncthreads();
    const bool xloc = vinfo[1] != 0u;
    const int vb = xloc ? (int)(bar.x * 32u + vinfo[0]) : bx;
    const int vc = xloc ? (int)(vinfo[0] * 8u + bar.x) : bx;
#undef GRID_BAR
#define GRID_BAR() do { if (xloc) xcd_local_barrier(ctl, bar.x); else xcd_barrier(bar); } while (0)
    p1_rows(P, lds, tid, lane, wave, vb);
    if (DUP == 2) p1_rows(P, lds, tid, lane, wave, vb);
    GRID_BAR();
    {
        { pg8::Gemm g{H, WinT, M, PROJ_LD, D}; pg8::StaticOrder S; S.init(M, PROJ_LD, G, vc);
          pg8::EpiQKU E{ACT, C2};
          pg8::gemm_phase<pg8::EpiQKU, pg8::StaticOrder, PG8_ALIGN, PG8_SP2>(lds, g, S, E); }
        { pg8::Gemm g{WinT + (size_t)PROJ_LD * D, H, SBW, M, D}; pg8::StaticOrder S; S.init(SBW, M, G, vc);
          pg8::EpiVT E{ACT};
          pg8::gemm_phase<pg8::EpiVT, pg8::StaticOrder, PG8_ALIGN, PG8_SP2>(lds, g, S, E); }
        if (DUP == 20) { pg8::Gemm g{H, WinT, M, PROJ_LD, D}; pg8::StaticOrder S; S.init(M, PROJ_LD, G, vc);
          pg8::EpiQKU E{ACT, C2};
          pg8::gemm_phase<pg8::EpiQKU, pg8::StaticOrder, PG8_ALIGN, PG8_SP2>(lds, g, S, E); }
        if (DUP == 21) { pg8::Gemm g{WinT + (size_t)PROJ_LD * D, H, SBW, M, D}; pg8::StaticOrder S; S.init(SBW, M, G, vc);
          pg8::EpiVT E{ACT};
          pg8::gemm_phase<pg8::EpiVT, pg8::StaticOrder, PG8_ALIGN, PG8_SP2>(lds, g, S, E); }
    }
    GRID_BAR();
    p3_mixers(P, lds, tid, lane, wave, vb);
    if (DUP == 3) p3_mixers(P, lds, tid, lane, wave, vb, 3 + 4);
    if (DUP == 31) p3_mixers(P, lds, tid, lane, wave, vb, 1 + 4);
    if (DUP == 33) p3_mixers(P, lds, tid, lane, wave, vb, 1 + 8);
    if (DUP == 34) p3_mixers(P, lds, tid, lane, wave, vb, 1 + 16);
    if (DUP == 32) p3_mixers(P, lds, tid, lane, wave, vb, 2);
    GRID_BAR();
    {
        pg8::Gemm g{CAT, WoT, M, D, D}; pg8::StaticOrder S; S.init(M, D, G, vc);
        pg8::EpiBf16<0> E{MIX, D, nullptr, 0, 0, 1.f};
        pg8::gemm_phase<pg8::EpiBf16<0>, pg8::StaticOrder, PG8_ALIGN, PG8_SP2>(lds, g, S, E);
        if (DUP == 4) pg8::gemm_phase<pg8::EpiBf16<0>, pg8::StaticOrder, PG8_ALIGN, PG8_SP2>(lds, g, S, E);
    }
    GRID_BAR();
    p5_rows(P, lane, wave, vb);
    if (DUP == 5) p5_rows(P, lane, wave, vb);
    GRID_BAR();
    {
        pg8::Gemm g{H, WguT, M, 2 * DFF, D}; pg8::StaticOrder S; S.init(M, 2 * DFF, G, vc);
        pg8::EpiSwiGLU E{ACT, DFF};
        pg8::gemm_phase<pg8::EpiSwiGLU, pg8::StaticOrder, PG8_ALIGN, PG8_SP2>(lds, g, S, E);
        if (DUP == 6) pg8::gemm_phase<pg8::EpiSwiGLU, pg8::StaticOrder, PG8_ALIGN, PG8_SP2>(lds, g, S, E);
    }
    GRID_BAR();
    {
        pg8::Gemm g{ACT, WdT, M, D, DFF}; pg8::StaticOrder S; S.init(M, D, G, vc);
        pg8::EpiBf16<0> E{MIX, D, nullptr, 0, 0, 1.f};
        pg8::gemm_phase<pg8::EpiBf16<0>, pg8::StaticOrder, PG8_ALIGN, PG8_SP2>(lds, g, S, E);
        if (DUP == 7) pg8::gemm_phase<pg8::EpiBf16<0>, pg8::StaticOrder, PG8_ALIGN, PG8_SP2>(lds, g, S, E);
    }
    GRID_BAR();
    if (DUP == 9) { for (int i = 0; i < 16; ++i) GRID_BAR(); }
    p8_rows(P, lane, wave, vb);
}

extern "C" void kernel_launch(void* const* d_in, const int* in_sizes, int n_in, void* d_out, int out_size, void* d_ws, size_t ws_size, hipStream_t stream) {
    static int grid = 0;
    if (grid == 0) {
        if (n_in != 15 || in_sizes[0] != M * D || out_size != M * D || ws_size < WS_END) { fprintf(stderr, "kernel_launch: unexpected shapes (n_in %d, in0 %d, out %d, ws %zu); nothing launched\n", n_in, n_in > 0 ? in_sizes[0] : -1, out_size, ws_size); grid = -1; return; }
        int dev = 0, cus = 0, per_cu = 0;
        if (hipGetDevice(&dev) != hipSuccess || hipDeviceGetAttribute(&cus, hipDeviceAttributeMultiprocessorCount, dev) != hipSuccess) { grid = -1; return; }
        if (hipFuncSetAttribute((const void*)hybrid_fwd, hipFuncAttributeMaxDynamicSharedMemorySize, LDS_BYTES) != hipSuccess) { fprintf(stderr, "kernel_launch: hipFuncSetAttribute failed\n"); grid = -1; return; }
        if (hipOccupancyMaxActiveBlocksPerMultiprocessor(&per_cu, (const void*)hybrid_fwd, NWAVES * 64, LDS_BYTES) != hipSuccess || per_cu < 1) { fprintf(stderr, "kernel_launch: occupancy query says %d blocks per CU\n", per_cu); per_cu = 1; }
        (void)hipGetLastError();
        grid = cus * per_cu;
        if (grid != 256) { fprintf(stderr, "kernel_launch: built for a 256-workgroup cooperative grid (256 CUs x 1 workgroup), got %d x %d; nothing launched\n", cus, per_cu); grid = -1; return; }
    }
    if (grid < 0) return;
    if (hipMemsetAsync((char*)d_ws + WS_CTL, 0, CTL_BYTES, stream) != hipSuccess) { fprintf(stderr, "kernel_launch: memset of the barrier words failed\n"); return; }
    Params p{};
    p.x = (const float*)d_in[0]; p.c = (const float*)d_in[1]; p.w_cond = (const float*)d_in[2]; p.b_cond = (const float*)d_in[3]; p.g_mix_pre = (const float*)d_in[4]; p.g_mix_post = (const float*)d_in[5];
    p.w_in = (const float*)d_in[6]; p.w_pool = (const float*)d_in[7]; p.pool_scale = (const float*)d_in[8]; p.w_out = (const float*)d_in[9]; p.g_ffn_pre = (const float*)d_in[10]; p.g_ffn_post = (const float*)d_in[11];
    p.w_gate = (const float*)d_in[12]; p.w_up = (const float*)d_in[13]; p.w_down = (const float*)d_in[14];
    p.out = (float*)d_out; p.ws = (unsigned char*)d_ws;
    void* args[] = {&p};
    const hipError_t e = hipLaunchCooperativeKernel((const void*)hybrid_fwd, dim3(grid), dim3(NWAVES * 64), args, LDS_BYTES, stream);
    if (e != hipSuccess) fprintf(stderr, "kernel_launch: cooperative launch failed: %s (grid %d)\n", hipGetErrorString(e), grid);
}
```

```cpp
#include <hip/hip_runtime.h>
#include <hip/hip_cooperative_groups.h>
#include <cstdio>
#include <cstdint>
namespace cg = cooperative_groups;
namespace pg8 {
#define PG8_LAS __attribute__((address_space(3)))
typedef unsigned short bf16_t;
typedef short bf16x8 __attribute__((ext_vector_type(8)));
typedef float f32x4 __attribute__((ext_vector_type(4)));
typedef unsigned u32x4 __attribute__((ext_vector_type(4)));
constexpr int BM = 256, BK = 64, HALF = 128, HTB = HALF * BK * 2  , STAGE_BYTES = 8 * HTB, NXCD = 8, WGM = 8;

__host__ __device__ __forceinline__ int lds_byte(int r, int c) { const int st = (r >> 4) * 2 + (c >> 5), rr = r & 15, cc = c & 31, ob = rr * 64 + cc * 2; return st * 1024 + (ob ^ (((ob >> 9) & 1) << 5)); }
__host__ __device__ __forceinline__ void stage_rc(int b, int& R, int& C) { const int st = b / 1024, sb = b % 1024, swz = sb ^ (((sb >> 9) & 1) << 5); R = (st >> 1) * 16 + swz / 64; C = (st & 1) * 32 + (swz % 64) / 2; }
__host__ __device__ __forceinline__ int perm32(int rho) { const int n = rho >> 4, i = rho & 15; return 8 * (i >> 2) + 4 * n + (i & 3); }

struct Unit { int pm, pn; };
struct Gemm { const bf16_t* A; const bf16_t* Bt; int M, N, K; };

struct StaticOrder {
    int nM, nN, nwg, G, c;
    __host__ __device__ void init(int M, int N, int G_, int c_) { nM = M / BM; nN = N / BM; nwg = nM * nN; G = G_; c = c_; }
    __host__ __device__ bool next(int i, Unit& u) const {
        const long L = (long)i * G + c; if (L >= nwg) return false;
        int wgid = (int)L; { const int q = nwg / NXCD, r = nwg % NXCD, xcd = wgid % NXCD, off = wgid / NXCD; wgid = (xcd < r ? xcd * (q + 1) : r * (q + 1) + (xcd - r) * q) + off; }
        const int nig = WGM * nN, gid = wgid / nig, fm = gid * WGM, gsz = (nM - fm) < WGM ? (nM - fm) : WGM;
        u.pm = fm + ((wgid % nig) % gsz); u.pn = (wgid % nig) / gsz; return true;
    }
    __device__ __forceinline__ void a_ready(const Unit&) const {}
    __device__ __forceinline__ void done(const Unit&) const {}
};

__device__ __forceinline__ unsigned cvt_pk_bf16(float lo, float hi) { unsigned r; asm volatile("v_cvt_pk_bf16_f32 %0, %1, %2" : "=v"(r) : "v"(lo), "v"(hi)); return r; }
typedef float f32x2 __attribute__((ext_vector_type(2)));
__device__ __forceinline__ f32x2 gelu_pk(f32x2 v) {
    const f32x2 av = __builtin_elementwise_abs(v), d = av * 0.2316418882f + 1.0f;
    f32x2 t; t.x = __builtin_amdgcn_rcpf(d.x); t.y = __builtin_amdgcn_rcpf(d.y);
    f32x2 q = t * 0.5307027145f + (-0.7265760135f); q = q * t + 0.7107068705f; q = q * t + (-0.142248368f); q = q * t + 0.127414796f; q = q * t;
    const f32x2 s = (v * v) * (-0.72134752044f);
    f32x2 e; e.x = __builtin_amdgcn_exp2f(s.x); e.y = __builtin_amdgcn_exp2f(s.y);
    const f32x2 m = v * (q * e), r = v - m;
    f32x2 o; o.x = v.x < 0.f ? m.x : r.x; o.y = v.y < 0.f ? m.y : r.y; return o;
}

template <int ACT  > struct EpiBf16 {
    static constexpr bool PERM = true, AFTER_DRAIN = false; static_assert(ACT == 0 || ACT == 1, "EpiBf16: ACT is 0 (none) or 1 (gelu_pk)");
    bf16_t* O; int ldc; const float* bias; int split_cols; size_t split_stride; float scale0;
    __device__ __forceinline__ void operator()(const f32x4 (&acc)[2][2][4][2], const Unit& u, int wr, int wc, int fr, int fq) const {
        const int row0 = u.pm * BM + wr * 64 + fr; int colt = u.pn * BM; bf16_t* base = O;
        float sc = 1.f; if (split_cols) { const int t = colt / split_cols; base += (size_t)t * split_stride; colt -= t * split_cols; if (t == 0) sc = scale0; }
        const int col0 = colt + wc * 32 + 8 * fq, bcol0 = u.pn * BM + wc * 32 + 8 * fq;
        f32x4 bv[2][2];
#pragma unroll
        for (int bj = 0; bj < 2; ++bj)
#pragma unroll
            for (int n = 0; n < 2; ++n) bv[bj][n] = bias ? *(const f32x4*)(bias + bcol0 + bj * HALF + 4 * n) : (f32x4){0.f, 0.f, 0.f, 0.f};
#pragma unroll
        for (int ai = 0; ai < 2; ++ai)
#pragma unroll
            for (int m = 0; m < 4; ++m) { bf16_t* rowp = base + (size_t)(row0 + ai * HALF + m * 16) * ldc + col0;
#pragma unroll
                for (int bj = 0; bj < 2; ++bj) { f32x4 v0 = acc[ai][bj][m][0] + bv[bj][0], v1 = acc[ai][bj][m][1] + bv[bj][1];
                    if (ACT == 1) { f32x2 a = gelu_pk((f32x2){v0[0], v0[1]}), b = gelu_pk((f32x2){v0[2], v0[3]}), c = gelu_pk((f32x2){v1[0], v1[1]}), d = gelu_pk((f32x2){v1[2], v1[3]});
                        v0 = (f32x4){a.x, a.y, b.x, b.y}; v1 = (f32x4){c.x, c.y, d.x, d.y}; }
                    v0 = v0 * sc; v1 = v1 * sc; u32x4 w; w.x = cvt_pk_bf16(v0[0], v0[1]); w.y = cvt_pk_bf16(v0[2], v0[3]); w.z = cvt_pk_bf16(v1[0], v1[1]); w.w = cvt_pk_bf16(v1[2], v1[3]);
                    *(u32x4*)(rowp + bj * HALF) = w; } }
    }
};
struct EpiSwiGLU {
    static constexpr bool PERM = true, AFTER_DRAIN = false;
    bf16_t* O; int ldc;
    __device__ __forceinline__ void operator()(const f32x4 (&acc)[2][2][4][2], const Unit& u, int wr, int wc, int fr, int fq) const {
        const int row0 = u.pm * BM + wr * 64 + fr; const int col0 = u.pn * HALF + wc * 32 + 8 * fq;
#pragma unroll
        for (int ai = 0; ai < 2; ++ai)
#pragma unroll
            for (int m = 0; m < 4; ++m) { bf16_t* rowp = O + (size_t)(row0 + ai * HALF + m * 16) * ldc + col0;
                float r[8];
#pragma unroll
                for (int n = 0; n < 2; ++n)
#pragma unroll
                    for (int p = 0; p < 2; ++p) {
                        const f32x2 g = {acc[ai][0][m][n][2 * p], acc[ai][0][m][n][2 * p + 1]}, up = {acc[ai][1][m][n][2 * p], acc[ai][1][m][n][2 * p + 1]};
                        const f32x2 t = g * -1.4426950408889634f; f32x2 e; e.x = __builtin_amdgcn_exp2f(t.x); e.y = __builtin_amdgcn_exp2f(t.y);
                        const f32x2 d = e + 1.0f; f32x2 q; q.x = __builtin_amdgcn_rcpf(d.x); q.y = __builtin_amdgcn_rcpf(d.y);
                        const f32x2 o = (g * up) * q; r[n * 4 + 2 * p] = o.x; r[n * 4 + 2 * p + 1] = o.y; }
                u32x4 w; w.x = cvt_pk_bf16(r[0], r[1]); w.y = cvt_pk_bf16(r[2], r[3]); w.z = cvt_pk_bf16(r[4], r[5]); w.w = cvt_pk_bf16(r[6], r[7]);
                *(u32x4*)rowp = w; }
    }
};

struct EpiQKU {
    static constexpr bool PERM = true, AFTER_DRAIN = false;
    bf16_t* S0; float qscale;
    __device__ __forceinline__ void operator()(const f32x4 (&acc)[2][2][4][2], const Unit& u, int wr, int wc, int fr, int fq) const {
        const int sec = u.pn >> 1, cbase = (u.pn & 1) * BM + wc * 32 + 8 * fq; const float sc = sec == 0 ? qscale : 1.0f;
#pragma unroll
        for (int ai = 0; ai < 2; ++ai)
#pragma unroll
            for (int m = 0; m < 4; ++m) { const int tok = u.pm * BM + ai * HALF + wr * 64 + m * 16 + fr, b = tok >> 11, s = tok & 2047, tile = s >> 5, key = s & 31;
                const int slot = sec == 0 ? key : ((key & ~12) | ((key & 4) << 1) | ((key & 8) >> 1));
#pragma unroll
                for (int bj = 0; bj < 2; ++bj) { const int c = cbase + bj * HALF, h = c >> 6, d = c & 63;
                    bf16_t* sb = S0 + (size_t)(b >> 1) * ((size_t)4096 * 2816) + (size_t)(b & 1) * ((size_t)1 << 20) + (size_t)sec * ((size_t)2 << 20);
                    bf16_t* p = sec == 2 ? sb + (size_t)s * 512 + c
                                         : sb + (((size_t)h * 64 + tile) * 4 + (d >> 4)) * 512 + ((d >> 3) & 1) * 256 + slot * 8;
                    const f32x4 v0 = acc[ai][bj][m][0] * sc, v1 = acc[ai][bj][m][1] * sc;
                    u32x4 w; w.x = cvt_pk_bf16(v0[0], v0[1]); w.y = cvt_pk_bf16(v0[2], v0[3]); w.z = cvt_pk_bf16(v1[0], v1[1]); w.w = cvt_pk_bf16(v1[2], v1[3]);
                    *(u32x4*)p = w; } }
    }
};

struct EpiVT {
    static constexpr bool PERM = true, AFTER_DRAIN = false;
    bf16_t* O;
    __device__ __forceinline__ void operator()(const f32x4 (&acc)[2][2][4][2], const Unit& u, int wr, int wc, int fr, int fq) const {
        const int row0 = u.pm * BM + wr * 64 + fr, col0 = u.pn * BM + wc * 32 + 8 * fq;
#pragma unroll
        for (int ai = 0; ai < 2; ++ai)
#pragma unroll
            for (int m = 0; m < 4; ++m) { const int c = row0 + ai * HALF + m * 16, h = c >> 6, d = c & 63;
#pragma unroll
                for (int bj = 0; bj < 2; ++bj) { const int tok = col0 + bj * HALF, b = tok >> 11, s = tok & 2047;
                    bf16_t* p = O + (size_t)(b >> 1) * ((size_t)4096 * 2816) + (size_t)(b & 1) * ((size_t)1 << 20) + ((size_t)6 << 20) + ((size_t)h * 64 + (s >> 5)) * 2048 + (((d >> 5) * 2 + ((s >> 4) & 1)) * 2 + ((s >> 3) & 1)) * 256 + (d & 31) * 8;
                    const f32x4 v0 = acc[ai][bj][m][0], v1 = acc[ai][bj][m][1];
                    u32x4 w; w.x = cvt_pk_bf16(v0[0], v0[1]); w.y = cvt_pk_bf16(v0[2], v0[3]); w.z = cvt_pk_bf16(v1[0], v1[1]); w.w = cvt_pk_bf16(v1[2], v1[3]);
                    *(u32x4*)p = w; } }
    }
};

template <class Epi, class Sched, bool ALIGN_EPI = false, bool SP2 = false>
__device__ __forceinline__ void gemm_phase(PG8_LAS unsigned char* lds, const Gemm g, const Sched& S, const Epi& E) {
    const int tid = threadIdx.x, wid = __builtin_amdgcn_readfirstlane(tid >> 6), lane = tid & 63, wr = wid >> 2, wc = wid & 3, fr = lane & 15, fq = lane >> 4;
    const int K = g.K, nt = K / BK;
    unsigned voffA[2], voffB[2];
#pragma unroll
    for (int i = 0; i < 2; ++i) { int R, C; stage_rc(tid * 16 + i * 8192, R, C); const int Rb = Epi::PERM ? ((R & ~31) + perm32(R & 31)) : R;
        voffA[i] = (unsigned)(R * K + C) * 2u; voffB[i] = (unsigned)(Rb * K + C) * 2u; }
    const size_t kstep = (size_t)(BK * 2);
    const size_t hstep = (size_t)HALF * K * 2;
    const size_t tstep = 2 * hstep;
    const unsigned ldsw = (unsigned)wid * 1024u;
    const int aoff = lds_byte(wr * 64 + fr, fq * 8), boff = lds_byte(wc * 32 + fr, fq * 8);
#define PG8_SA(b, h) (((b) * 2 + (h)) * HTB)
#define PG8_SB(b, h) ((4 + (b) * 2 + (h)) * HTB)
#define PG8_STAGE(bufoff, gbase, voff) do { _Pragma("unroll") for (int _i = 0; _i < 2; ++_i) \
        __builtin_amdgcn_global_load_lds((const unsigned*)((const char*)(gbase) + (voff)[_i]), (PG8_LAS unsigned*)(lds + (bufoff) + ldsw + _i * 8192), 16, 0, 0); } while (0)
#define PG8_LDA(dst, b, h) do { _Pragma("unroll") for (int m = 0; m < 4; ++m) _Pragma("unroll") for (int k = 0; k < 2; ++k) dst[m][k] = *(const PG8_LAS bf16x8*)(lds + PG8_SA(b, h) + aoff + m * 2048 + k * 1024); } while (0)
#define PG8_LDB(dst, b, h) do { _Pragma("unroll") for (int n = 0; n < 2; ++n) _Pragma("unroll") for (int k = 0; k < 2; ++k) dst[n][k] = *(const PG8_LAS bf16x8*)(lds + PG8_SB(b, h) + boff + n * 2048 + k * 1024); } while (0)
#define PG8_MMA(ai, bj, At, Bt) do { __builtin_amdgcn_s_setprio(1); _Pragma("unroll") for (int m = 0; m < 4; ++m) _Pragma("unroll") for (int n = 0; n < 2; ++n) _Pragma("unroll") for (int k = 0; k < 2; ++k) \
        acc[ai][bj][m][n] = __builtin_amdgcn_mfma_f32_16x16x32_bf16(Bt[n][k], At[m][k], acc[ai][bj][m][n], 0, 0, 0); __builtin_amdgcn_s_setprio(0); } while (0)
#define PG8_WAIT_V(n) asm volatile("s_waitcnt vmcnt(" #n ")" ::: "memory")
#define PG8_WAIT_L(n) asm volatile("s_waitcnt lgkmcnt(" #n ")" ::: "memory")
#define PG8_BAR __builtin_amdgcn_s_barrier()
#define PG8_SCHED __builtin_amdgcn_sched_barrier(0)
    Unit cur, nxt; int ui = 0;
    if (!S.next(0, cur)) return;
    f32x4 acc[2][2][4][2];
#pragma unroll
    for (int a = 0; a < 2; ++a)
#pragma unroll
        for (int b = 0; b < 2; ++b)
#pragma unroll
            for (int m = 0; m < 4; ++m)
#pragma unroll
                for (int n = 0; n < 2; ++n) acc[a][b][m][n] = (f32x4){0.f, 0.f, 0.f, 0.f};
    bf16x8 At[4][2], B0[2][2], B1[2][2];
    const char* cA = (const char*)g.A + (size_t)cur.pm * tstep; const char* cB = (const char*)g.Bt + (size_t)cur.pn * tstep;
    S.a_ready(cur);
    if constexpr (SP2) {
        PG8_STAGE(PG8_SB(0, 0), cB, voffB); PG8_STAGE(PG8_SB(0, 1), cB + hstep, voffB); PG8_STAGE(PG8_SA(0, 0), cA, voffA); PG8_STAGE(PG8_SA(0, 1), cA + hstep, voffA);
        if (wr == 1) PG8_BAR;
        PG8_WAIT_V(2); PG8_BAR;
        PG8_STAGE(PG8_SB(1, 0), cB + kstep, voffB); PG8_STAGE(PG8_SA(1, 0), cA + kstep, voffA); PG8_STAGE(PG8_SB(1, 1), cB + hstep + kstep, voffB);
        PG8_WAIT_V(6); PG8_BAR;
    } else {
        PG8_STAGE(PG8_SB(0, 0), cB, voffB); PG8_STAGE(PG8_SA(0, 0), cA, voffA); PG8_STAGE(PG8_SB(0, 1), cB + hstep, voffB); PG8_STAGE(PG8_SA(0, 1), cA + hstep, voffA);
        if (wr == 1) PG8_BAR;
        PG8_WAIT_V(4); PG8_BAR;
        PG8_STAGE(PG8_SB(1, 0), cB + kstep, voffB); PG8_STAGE(PG8_SA(1, 0), cA + kstep, voffA); PG8_STAGE(PG8_SB(1, 1), cB + hstep + kstep, voffB);
        PG8_WAIT_V(6); PG8_BAR;
    }
    for (;;) {
        const bool has_next = S.next(ui + 1, nxt);
        const char* nA = has_next ? (const char*)g.A + (size_t)nxt.pm * tstep : cA; const char* nB = has_next ? (const char*)g.Bt + (size_t)nxt.pn * tstep : cB;
        for (int t = 0; t < nt; t += 2) {
            const bool last = (t == nt - 2);
            const char* a1 = cA + (size_t)(t + 1) * kstep;
            const char* a2 = last ? nA : cA + (size_t)(t + 2) * kstep; const char* b2 = last ? nB : cB + (size_t)(t + 2) * kstep;
            const char* a3 = a2 + kstep; const char* b3 = b2 + kstep;
            if (last && has_next) S.a_ready(nxt);
            if constexpr (SP2) {
            PG8_LDB(B0, 0, 0); PG8_LDB(B1, 0, 1); PG8_SCHED; PG8_LDA(At, 0, 0); PG8_STAGE(PG8_SA(1, 1), a1 + hstep, voffA);
            PG8_WAIT_V(8); PG8_WAIT_L(0); PG8_BAR; PG8_MMA(0, 0, At, B0); PG8_MMA(0, 1, At, B1); PG8_BAR; PG8_SCHED;
            PG8_LDA(At, 0, 1); PG8_STAGE(PG8_SB(0, 0), b2, voffB); PG8_STAGE(PG8_SB(0, 1), b2 + hstep, voffB); PG8_STAGE(PG8_SA(0, 0), a2, voffA);
            PG8_WAIT_V(8); PG8_WAIT_L(0); PG8_BAR; PG8_MMA(1, 0, At, B0); PG8_MMA(1, 1, At, B1); PG8_BAR; PG8_SCHED;
            PG8_LDB(B0, 1, 0); PG8_LDB(B1, 1, 1); PG8_SCHED; PG8_LDA(At, 1, 0); PG8_STAGE(PG8_SA(0, 1), a2 + hstep, voffA);
            PG8_WAIT_V(8); PG8_WAIT_L(0); PG8_BAR; PG8_MMA(0, 0, At, B0); PG8_MMA(0, 1, At, B1); PG8_BAR; PG8_SCHED;
            PG8_LDA(At, 1, 1); PG8_STAGE(PG8_SB(1, 0), b3, voffB); PG8_STAGE(PG8_SB(1, 1), b3 + hstep, voffB); PG8_STAGE(PG8_SA(1, 0), a3, voffA);
            PG8_WAIT_V(8); PG8_WAIT_L(0); PG8_BAR; PG8_MMA(1, 0, At, B0); PG8_MMA(1, 1, At, B1); PG8_BAR; PG8_SCHED;
            } else {
            PG8_LDB(B0, 0, 0); PG8_SCHED; PG8_LDA(At, 0, 0); PG8_STAGE(PG8_SA(1, 1), a1 + hstep, voffA);
            PG8_WAIT_L(8); PG8_BAR; PG8_WAIT_L(0); PG8_MMA(0, 0, At, B0); PG8_BAR; PG8_SCHED;
            PG8_LDB(B1, 0, 1); PG8_STAGE(PG8_SB(0, 0), b2, voffB);
            PG8_BAR; PG8_WAIT_L(0); PG8_MMA(0, 1, At, B1); PG8_BAR;
            PG8_LDA(At, 0, 1); PG8_STAGE(PG8_SA(0, 0), a2, voffA);
            PG8_BAR; PG8_WAIT_L(0); PG8_MMA(1, 0, At, B0); PG8_BAR; PG8_SCHED;
            PG8_STAGE(PG8_SB(0, 1), b2 + hstep, voffB);
            PG8_WAIT_V(6); PG8_BAR; PG8_MMA(1, 1, At, B1); PG8_BAR;
            PG8_LDB(B0, 1, 0); PG8_SCHED; PG8_LDA(At, 1, 0); PG8_STAGE(PG8_SA(0, 1), a2 + hstep, voffA);
            PG8_WAIT_L(8); PG8_BAR; PG8_WAIT_L(0); PG8_MMA(0, 0, At, B0); PG8_BAR; PG8_SCHED;
            PG8_LDB(B1, 1, 1); PG8_STAGE(PG8_SB(1, 0), b3, voffB);
            PG8_BAR; PG8_WAIT_L(0); PG8_MMA(0, 1, At, B1); PG8_BAR;
            PG8_LDA(At, 1, 1); PG8_STAGE(PG8_SA(1, 0), a3, voffA);
            PG8_BAR; PG8_WAIT_L(0); PG8_MMA(1, 0, At, B0); PG8_BAR; PG8_SCHED;
            PG8_STAGE(PG8_SB(1, 1), b3 + hstep, voffB);
            PG8_WAIT_V(6); PG8_BAR; PG8_MMA(1, 1, At, B1); PG8_BAR;
            }
        }
        if constexpr (ALIGN_EPI) { if (wr == 0) PG8_BAR; }
        if constexpr (!Epi::AFTER_DRAIN) { E(acc, cur, wr, wc, fr, fq); S.done(cur); }
        if (!has_next) break;
#pragma unroll
        for (int a = 0; a < 2; ++a)
#pragma unroll
            for (int b = 0; b < 2; ++b)
#pragma unroll
                for (int m = 0; m < 4; ++m)
#pragma unroll
                    for (int n = 0; n < 2; ++n) acc[a][b][m][n] = (f32x4){0.f, 0.f, 0.f, 0.f};
        cur = nxt; cA = nA; cB = nB; ++ui;
        if constexpr (ALIGN_EPI) { if (wr == 1) PG8_BAR; }
    }
    PG8_WAIT_V(0);
    if constexpr (!ALIGN_EPI) { if (wr == 0) PG8_BAR; }
    PG8_BAR;
    if constexpr (Epi::AFTER_DRAIN) { E.fused(acc, cur, wr, wc, fr, fq, lds, wid, lane); S.done(cur); }
#undef PG8_SA
#undef PG8_SB
#undef PG8_STAGE
#undef PG8_LDA
#undef PG8_LDB
#undef PG8_MMA
#undef PG8_WAIT_V
#undef PG8_WAIT_L
#undef PG8_BAR
#undef PG8_SCHED
}
}

#ifndef PG8_SP2
#define PG8_SP2 true
#endif
#ifndef PG8_ALIGN
#define PG8_ALIGN true
#endif

constexpr int BATCH = 16, SEQ = 2048, D = 1024, M = BATCH * SEQ;
constexpr int NH = 8, HD = 64, SBW = 512, PW = 512, DFF = 2816, NMOD = 6;
constexpr int PROJ_LD = 1536;
constexpr float EPS = 1e-6f;
constexpr float C2 = 0.125f * 1.4426950408889634f;
constexpr int NWAVES = 8;
#ifndef DUP
#define DUP 0
#endif
constexpr size_t MiB = 1u << 20;
constexpr size_t WS_MOD = 0;
constexpr size_t WS_CTL = 512 * 1024, CTL_BYTES = 32768;
constexpr size_t WS_WIN = 1 * MiB;
constexpr size_t WS_WO = 5 * MiB;
constexpr size_t WS_WGU = 7 * MiB;
constexpr size_t WS_WD = 18 * MiB;
constexpr size_t WS_H = 24 * MiB;
constexpr size_t WS_MIX = 88 * MiB;
constexpr size_t WS_ACT = 152 * MiB;
constexpr size_t SLAB_E = (size_t)4096 * DFF;
constexpr size_t Q_OFF = 0, K_OFF = (size_t)2 << 20, U_OFF = (size_t)4 << 20, V_OFF = (size_t)6 << 20;
constexpr size_t WS_CAT = 328 * MiB;
constexpr size_t WS_X1 = 392 * MiB;
constexpr size_t WS_XB = 456 * MiB;
constexpr size_t WS_PART = 457 * MiB;
constexpr size_t WS_END = 464 * MiB;
static_assert(V_OFF + ((size_t)2 << 20) <= SLAB_E, "slab sections");
static_assert(WS_ACT + (size_t)M * DFF * 2 <= WS_END, "ws map");
constexpr int LDS_BYTES = 147456;

#define GAS __attribute__((address_space(1)))
#define LAS __attribute__((address_space(3)))
typedef unsigned short bf16;
typedef unsigned v4u __attribute__((ext_vector_type(4)));
typedef unsigned v2u __attribute__((ext_vector_type(2)));
typedef float f32x4 __attribute__((ext_vector_type(4)));
typedef float f32x16 __attribute__((ext_vector_type(16)));
typedef short bf16x8 __attribute__((ext_vector_type(8)));
typedef float f32x2_t __attribute__((ext_vector_type(2))); typedef __bf16 bf16x2_t __attribute__((ext_vector_type(2)));
__device__ __forceinline__ unsigned pk2(float lo, float hi) { f32x2_t v = {lo, hi}; bf16x2_t b = __builtin_convertvector(v, bf16x2_t); return __builtin_bit_cast(unsigned, b); }
__device__ __forceinline__ float bf_lo(unsigned w) { return __uint_as_float(w << 16); }
__device__ __forceinline__ float bf_hi(unsigned w) { return __uint_as_float(w & 0xffff0000u); }
__device__ __forceinline__ float wave_sum(float v) {
#pragma unroll
    for (int o = 1; o < 64; o <<= 1) v += __shfl_xor(v, o);
    return v;
}

__host__ __device__ __forceinline__ size_t slab_off(int b) { return (size_t)(b >> 1) * SLAB_E + (size_t)(b & 1) * ((size_t)1 << 20); }

struct Params {
    const float *x, *c, *w_cond, *b_cond, *g_mix_pre, *g_mix_post, *w_in, *w_pool, *pool_scale, *w_out, *g_ffn_pre, *g_ffn_post, *w_gate, *w_up, *w_down;
    float* out; unsigned char* ws; int use_cg_sync; int pad;
};

__device__ __forceinline__ void transpose_item(const float* W, int ldw, bf16* WT, int ldt, int k0, int n0, int drow0, LAS float* scr, int lane) {
#pragma unroll
    for (int i = 0; i < 32; ++i) { const int kk = 2 * i + (lane >> 5); scr[kk * 33 + (lane & 31)] = __builtin_nontemporal_load(W + (size_t)(k0 + kk) * ldw + n0 + (lane & 31)); }
    asm volatile("s_waitcnt lgkmcnt(0)" ::: "memory");
    const int c = lane & 7;
#pragma unroll
    for (int j = 0; j < 4; ++j) { const int n = (lane >> 3) + 8 * j; const LAS float* s = scr + (8 * c) * 33 + n;
        v4u o; o.x = pk2(s[0 * 33], s[1 * 33]); o.y = pk2(s[2 * 33], s[3 * 33]); o.z = pk2(s[4 * 33], s[5 * 33]); o.w = pk2(s[6 * 33], s[7 * 33]);
        *(v4u*)(WT + (size_t)(drow0 + n) * ldt + k0 + 8 * c) = o; }
    asm volatile("s_waitcnt lgkmcnt(0)" ::: "memory");
}

__device__ __forceinline__ void p0_prologue(const Params& P, LAS unsigned char* lds, int tid, int lane, int wave, int mode = 3) {
    LAS float* sc = (LAS float*)lds;
    LAS float* red = (LAS float*)(lds + 4096);
    float* part = (float*)(P.ws + WS_PART);
    const int item = blockIdx.x, kc = item >> 4, cc = item & 15, cg4 = tid % 96, ks = tid / 96; const bool do_mod = (mode & 1) && item < 256;
    f32x4 wv[13];
    {   const float* wp = P.w_cond + (size_t)(64 * kc + ks) * (NMOD * D) + 384 * cc + 4 * cg4;
#pragma unroll
        for (int i = 0; i < 13; ++i) wv[i] = (do_mod && tid < 480 && ks + 5 * i < 64) ? __builtin_nontemporal_load((const f32x4*)(wp + (size_t)(5 * i) * (NMOD * D))) : (f32x4){0.f, 0.f, 0.f, 0.f}; }
    LAS float* scr = (LAS float*)(lds + wave * 16384);
    const int gw = blockIdx.x * NWAVES + wave, NGW = gridDim.x * NWAVES;
    bf16* WinT = (bf16*)(P.ws + WS_WIN); bf16* WoT = (bf16*)(P.ws + WS_WO); bf16* WguT = (bf16*)(P.ws + WS_WGU); bf16* WdT = (bf16*)(P.ws + WS_WD);
    constexpr int I_IN = 16 * 64, I_O = 8 * 32, I_G = 16 * 88, I_D = 44 * 32, I_E = 16 * 64;
    constexpr int NITEMS = I_IN + I_O + 2 * I_G + I_D + I_E;
    if (mode & 2) for (int it = gw; it < NITEMS; it += NGW) {
        int r = it;
        if (r < I_IN) { const int kb = r >> 6, nb = r & 63, n0 = nb * 32; const int sec = n0 >> 9;
            const int drow = (sec == 2) ? 1536 + (n0 - 1024) : (sec == 3) ? 1024 + (n0 - 1536) : n0;
            transpose_item(P.w_in, 2048, WinT, 1024, kb * 64, n0, drow, scr, lane); continue; } r -= I_IN;
        if (r < I_O) { const int kb = r >> 5, nb = r & 31; transpose_item(P.w_out, 1024, WoT, 1024, kb * 64, nb * 32, nb * 32, scr, lane); continue; } r -= I_O;
        if (r < I_G) { const int kb = r / 88, nb = r % 88, n0 = nb * 32; transpose_item(P.w_gate, DFF, WguT, 1024, kb * 64, n0, (n0 >> 7) * 256 + (n0 & 127), scr, lane); continue; } r -= I_G;
        if (r < I_G) { const int kb = r / 88, nb = r % 88, n0 = nb * 32; transpose_item(P.w_up, DFF, WguT, 1024, kb * 64, n0, (n0 >> 7) * 256 + 128 + (n0 & 127), scr, lane); continue; } r -= I_G;
        if (r < I_D) { const int kb = r >> 5, nb = r & 31; transpose_item(P.w_down, 1024, WdT, DFF, kb * 64, nb * 32, nb * 32, scr, lane); continue; } r -= I_D;
        {
            const int nb = r & 15, kc = r >> 4, g = kc >> 4, kl0 = (kc & 15) * 8, n = nb * 64 + lane;
            float acc[8];
#pragma unroll
            for (int i = 0; i < 8; ++i) acc[i] = 0.f;
            const float* wpp = P.w_pool + (size_t)g * 128 * 128 + (size_t)kl0 * 128;
            const float* wop = P.w_out + (size_t)(512 + g * 128) * 1024 + n;
            const float* psp = P.pool_scale + g * 128;
#pragma unroll 8
            for (int c = 0; c < 128; ++c) { const float wo = wop[(size_t)c * 1024] * psp[c];
#pragma unroll
                for (int i = 0; i < 8; ++i) acc[i] += wpp[i * 128 + c] * wo; }
            v4u o; o.x = pk2(acc[0], acc[1]); o.y = pk2(acc[2], acc[3]); o.z = pk2(acc[4], acc[5]); o.w = pk2(acc[6], acc[7]);
            *(v4u*)(WoT + (size_t)n * 1024 + 512 + g * 128 + kl0) = o;
        }
    }
    if (do_mod) {
        __syncthreads();
        for (int i = tid; i < 1024; i += NWAVES * 64) { const int b = i >> 6, kk = i & 63; const float v = P.c[b * D + 64 * kc + kk]; sc[kk * 16 + b] = v / (1.0f + __expf(-v)); }
        __syncthreads();
        if (tid < 480) {
            f32x4 acc[16];
#pragma unroll
            for (int b = 0; b < 16; ++b) acc[b] = (f32x4){0.f, 0.f, 0.f, 0.f};
#pragma unroll
            for (int i = 0; i < 13; ++i) { const int kk = (ks + 5 * i < 64) ? ks + 5 * i : 63; const LAS f32x4* s4 = (const LAS f32x4*)(sc + kk * 16);
#pragma unroll
                for (int q = 0; q < 4; ++q) { const f32x4 s = s4[q]; acc[4 * q + 0] += wv[i] * s[0]; acc[4 * q + 1] += wv[i] * s[1]; acc[4 * q + 2] += wv[i] * s[2]; acc[4 * q + 3] += wv[i] * s[3]; } }
#pragma unroll
            for (int b = 0; b < 16; ++b) *(LAS f32x4*)(red + (ks * 16 + b) * 384 + 4 * cg4) = acc[b];
        }
        __syncthreads();
        for (int idx = tid; idx < 16 * 384; idx += NWAVES * 64) { const int b = idx / 384, col = idx % 384; float s = 0.f;
#pragma unroll
            for (int ks2 = 0; ks2 < 5; ++ks2) s += red[(ks2 * 16 + b) * 384 + col];
            part[((size_t)kc * 16 + b) * (NMOD * D) + 384 * cc + col] = s; }
        __syncthreads();
    }
}

__device__ __forceinline__ f32x4 unpack_bf4(v2u w) { return (f32x4){bf_lo(w.x), bf_hi(w.x), bf_lo(w.y), bf_hi(w.y)}; }
__device__ __forceinline__ float sumsq4(const f32x4 (&v)[4]) { float ss = 0.f;
#pragma unroll
    for (int j = 0; j < 4; ++j) ss += (v[j][0] * v[j][0] + v[j][1] * v[j][1]) + (v[j][2] * v[j][2] + v[j][3] * v[j][3]);
    return ss; }
constexpr int NPF = 3;
__device__ __forceinline__ void p1_rows(const Params& P, LAS unsigned char* lds, int tid, int lane, int wave, int vb) {
    const int gw = vb * NWAVES + wave, NGW = gridDim.x * NWAVES;
    float* mod = (float*)(P.ws + WS_MOD); bf16* H = (bf16*)(P.ws + WS_H); const float* part = (const float*)(P.ws + WS_PART);
    LAS float* ms = (LAS float*)lds;
    for (int ch = gw; ch < M / 16; ch += NGW) {
        const int r0 = ch * 16, b = r0 / SEQ;
        const f32x4* xb = (const f32x4*)(P.x + (size_t)r0 * D) + lane;
        f32x4 ring[NPF + 1][4];
#pragma unroll
        for (int r = 0; r < NPF; ++r)
#pragma unroll
            for (int j = 0; j < 4; ++j) ring[r][j] = __builtin_nontemporal_load(xb + (size_t)r * (D / 4) + 64 * j);
        {
            const int sub = ((ch - wave) / NWAVES) & 15;
            float sv[5]; int cols[5];
#pragma unroll
            for (int j = 0; j < 5; ++j) { cols[j] = j < 4 ? tid + 512 * j : 2048 + 256 * sub + (tid & 255); sv[j] = P.b_cond[cols[j]]; }
#pragma unroll 4
            for (int kc = 0; kc < 16; ++kc) { const float* pp = part + ((size_t)kc * 16 + b) * (NMOD * D);
#pragma unroll
                for (int j = 0; j < 5; ++j) sv[j] += pp[cols[j]]; }
            __syncthreads();
#pragma unroll
            for (int j = 0; j < 4; ++j) ms[cols[j]] = sv[j];
            if (tid < 256) mod[(size_t)b * (NMOD * D) + cols[4]] = sv[4];
            __syncthreads();
        }
        f32x4 a[4], sh[4];
#pragma unroll
        for (int j = 0; j < 4; ++j) { const int c0 = 4 * lane + 256 * j; const f32x4 g = *(const f32x4*)(P.g_mix_pre + c0), scl = *(const LAS f32x4*)(ms + D + c0); a[j] = g * (scl + 1.0f); sh[j] = *(const LAS f32x4*)(ms + c0); }
#pragma unroll 1
        for (int rb = 0; rb < 16; rb += NPF + 1)
#pragma unroll
        for (int rk = 0; rk < NPF + 1; ++rk) { const int r = rb + rk;
            if (r + NPF < 16) {
#pragma unroll
                for (int j = 0; j < 4; ++j) ring[(rk + NPF) % (NPF + 1)][j] = __builtin_nontemporal_load(xb + (size_t)(r + NPF) * (D / 4) + 64 * j); }
            const f32x4 (&v)[4] = ring[rk];
            const float rstd = 1.0f / sqrtf(wave_sum(sumsq4(v)) * (1.0f / D) + EPS);
            v2u* o8 = (v2u*)(H + (size_t)(r0 + r) * D) + lane;
#pragma unroll
            for (int j = 0; j < 4; ++j) { const f32x4 y = v[j] * rstd * a[j] + sh[j]; v2u w; w.x = pk2(y[0], y[1]); w.y = pk2(y[2], y[3]); o8[64 * j] = w; }
        }
    }
}
__device__ __forceinline__ void p5_rows(const Params& P, int lane, int wave, int vb) {
    const int gw = vb * NWAVES + wave, NGW = gridDim.x * NWAVES;
    const float* mod = (const float*)(P.ws + WS_MOD); bf16* H = (bf16*)(P.ws + WS_H); const bf16* MIX = (const bf16*)(P.ws + WS_MIX);
    for (int ch = gw; ch < M / 16; ch += NGW) {
        const int r0 = ch * 16, b = r0 / SEQ; const float* mb = mod + (size_t)b * (NMOD * D);
        const f32x4* xb = (const f32x4*)(P.x + (size_t)r0 * D) + lane; const v2u* mbp = (const v2u*)(MIX + (size_t)r0 * D) + lane;
        f32x4 rx[NPF + 1][4]; v2u rm[NPF + 1][4];
#pragma unroll
        for (int r = 0; r < NPF; ++r)
#pragma unroll
            for (int j = 0; j < 4; ++j) { rm[r][j] = __builtin_nontemporal_load(mbp + (size_t)r * (D / 4) + 64 * j); rx[r][j] = __builtin_nontemporal_load(xb + (size_t)r * (D / 4) + 64 * j); }
        f32x4 gm[4], a[4], sh[4];
#pragma unroll
        for (int j = 0; j < 4; ++j) { const int c0 = 4 * lane + 256 * j;
            gm[j] = *(const f32x4*)(mb + 2 * D + c0) * *(const f32x4*)(P.g_mix_post + c0);
            a[j] = *(const f32x4*)(P.g_ffn_pre + c0) * (*(const f32x4*)(mb + 4 * D + c0) + 1.0f); sh[j] = *(const f32x4*)(mb + 3 * D + c0); }
#pragma unroll 1
        for (int rb = 0; rb < 16; rb += NPF + 1)
#pragma unroll
        for (int rk = 0; rk < NPF + 1; ++rk) { const int r = rb + rk;
            if (r + NPF < 16) {
#pragma unroll
                for (int j = 0; j < 4; ++j) { rm[(rk + NPF) % (NPF + 1)][j] = __builtin_nontemporal_load(mbp + (size_t)(r + NPF) * (D / 4) + 64 * j); rx[(rk + NPF) % (NPF + 1)][j] = __builtin_nontemporal_load(xb + (size_t)(r + NPF) * (D / 4) + 64 * j); } }
            const size_t row = (size_t)(r0 + r);
            f32x4 mv[4], xv[4];
#pragma unroll
            for (int j = 0; j < 4; ++j) { mv[j] = unpack_bf4(rm[rk][j]); xv[j] = rx[rk][j]; }
            const float rstd = 1.0f / sqrtf(wave_sum(sumsq4(mv)) * (1.0f / D) + EPS);
#pragma unroll
            for (int j = 0; j < 4; ++j) xv[j] = xv[j] + gm[j] * (mv[j] * rstd);
            const float rstd2 = 1.0f / sqrtf(wave_sum(sumsq4(xv)) * (1.0f / D) + EPS);
            v2u* x8 = (v2u*)((bf16*)(P.ws + WS_X1) + row * D) + lane; v2u* o8 = (v2u*)(H + row * D) + lane;
#pragma unroll
            for (int j = 0; j < 4; ++j) { v2u xw; xw.x = pk2(xv[j][0], xv[j][1]); xw.y = pk2(xv[j][2], xv[j][3]); __builtin_nontemporal_store(xw, x8 + 64 * j);
                const f32x4 y = xv[j] * rstd2 * a[j] + sh[j]; v2u w; w.x = pk2(y[0], y[1]); w.y = pk2(y[2], y[3]); o8[64 * j] = w; }
        }
    }
}
__device__ __forceinline__ void p8_rows(const Params& P, int lane, int wave, int vb) {
    const int gw = vb * NWAVES + wave, NGW = gridDim.x * NWAVES;
    const float* mod = (const float*)(P.ws + WS_MOD); const bf16* FB = (const bf16*)(P.ws + WS_MIX); const bf16* X1 = (const bf16*)(P.ws + WS_X1);
    for (int ch = gw; ch < M / 16; ch += NGW) {
        const int r0 = ch * 16, b = r0 / SEQ; const float* mb = mod + (size_t)b * (NMOD * D);
        f32x4* ob = (f32x4*)(P.out + (size_t)r0 * D) + lane; const v2u* fbp = (const v2u*)(FB + (size_t)r0 * D) + lane; const v2u* xbp = (const v2u*)(X1 + (size_t)r0 * D) + lane;
        v2u rx[NPF + 1][4], rf[NPF + 1][4];
#pragma unroll
        for (int r = 0; r < NPF; ++r)
#pragma unroll
            for (int j = 0; j < 4; ++j) { rf[r][j] = __builtin_nontemporal_load(fbp + (size_t)r * (D / 4) + 64 * j); rx[r][j] = __builtin_nontemporal_load(xbp + (size_t)r * (D / 4) + 64 * j); }
        f32x4 gf[4];
#pragma unroll
        for (int j = 0; j < 4; ++j) { const int c0 = 4 * lane + 256 * j; gf[j] = *(const f32x4*)(mb + 5 * D + c0) * *(const f32x4*)(P.g_ffn_post + c0); }
#pragma unroll 1
        for (int rb = 0; rb < 16; rb += NPF + 1)
#pragma unroll
        for (int rk = 0; rk < NPF + 1; ++rk) { const int r = rb + rk;
            if (r + NPF < 16) {
#pragma unroll
                for (int j = 0; j < 4; ++j) { rf[(rk + NPF) % (NPF + 1)][j] = __builtin_nontemporal_load(fbp + (size_t)(r + NPF) * (D / 4) + 64 * j); rx[(rk + NPF) % (NPF + 1)][j] = __builtin_nontemporal_load(xbp + (size_t)(r + NPF) * (D / 4) + 64 * j); } }
            f32x4 fv[4];
#pragma unroll
            for (int j = 0; j < 4; ++j) fv[j] = unpack_bf4(rf[rk][j]);
            const float rstd = 1.0f / sqrtf(wave_sum(sumsq4(fv)) * (1.0f / D) + EPS);
#pragma unroll
            for (int j = 0; j < 4; ++j) __builtin_nontemporal_store(unpack_bf4(rx[rk][j]) + gf[j] * (fv[j] * rstd), ob + (size_t)r * (D / 4) + 64 * j);
        }
    }
}

template <int VAR> __device__ __forceinline__ void attn_unit(const bf16* PROJ, const bf16* VT, bf16* CAT, int b, int h, int qb, int lane) {
    const int r32 = lane & 31, hi = lane >> 5, t0 = qb * 32;
    const bf16* Qp = PROJ + slab_off(b) + Q_OFF + ((size_t)h * 64 + qb) * 2048 + lane * 8;
    bf16x8 qf[4];
#pragma unroll
    for (int d0 = 0; d0 < 4; ++d0) qf[d0] = *(const bf16x8*)(Qp + d0 * 512);
    const bf16* Kp = PROJ + slab_off(b) + K_OFF + (size_t)h * (SEQ * HD) + lane * 8;
    const bf16* Vp = VT + slab_off(b) + V_OFF + (size_t)h * (SEQ * HD) + lane * 8;
    f32x16 o0 = {}, o1 = {};
    float qc = 1.0f;
    bf16x8 ka[4], va[4], kb[4], vb[4], kc[4], vc[4];
#define LOADK(KF, jt) do { const int jt_ = (jt) > 0 ? (jt) : 0; const bf16* kp_ = Kp + jt_ * 2048; \
        _Pragma("unroll") for (int d0 = 0; d0 < 4; ++d0) KF[d0] = *(const bf16x8*)(kp_ + d0 * 512); } while (0)
#define LOADV(VF, jt) do { const int jt_ = (jt) > 0 ? (jt) : 0; const bf16* vp_ = Vp + jt_ * 2048; \
        VF[0] = *(const bf16x8*)(vp_); VF[1] = *(const bf16x8*)(vp_ + 512); VF[2] = *(const bf16x8*)(vp_ + 1024); VF[3] = *(const bf16x8*)(vp_ + 1536); } while (0)
#define TILE(KF, VF, jt, DIAG) do { \
        f32x16 s = {}; \
        _Pragma("unroll") for (int d0 = 0; d0 < 4; ++d0) s = __builtin_amdgcn_mfma_f32_32x32x16_bf16(KF[d0], qf[d0], s, 0, 0, 0); \
        LOADK(KF, (jt) - 3); \
        float e[16], dd[16]; \
        _Pragma("unroll") for (int r = 0; r < 16; ++r) { e[r] = __builtin_amdgcn_exp2f(__builtin_fminf(s[r], 120.0f)); dd[r] = 1.0f + e[r]; }     \
        if (DIAG) {                                                            \
            _Pragma("unroll") for (int r = 0; r < 16; ++r) { const int kk = 8 * hi + (r & 7) + 16 * (r >> 3); if (kk >= r32) { e[r] = 0.0f; dd[r] = 1.0f; } } } \
        const float G0 = ((dd[0] * dd[1]) * (dd[2] * dd[3])) * ((dd[4] * dd[5]) * (dd[6] * dd[7])); \
        const float G1 = ((dd[8] * dd[9]) * (dd[10] * dd[11])) * ((dd[12] * dd[13]) * (dd[14] * dd[15])); \
        const auto x0 = __builtin_amdgcn_permlane32_swap(__float_as_uint(G0), __float_as_uint(G0), false, false);     \
        const auto x1 = __builtin_amdgcn_permlane32_swap(__float_as_uint(G1), __float_as_uint(G1), false, false); \
        const float T0 = __uint_as_float(x0[0]) * __uint_as_float(x0[1]), T1 = __uint_as_float(x1[0]) * __uint_as_float(x1[1]); \
          \
        float r1 = __builtin_amdgcn_rcpf(qc * (hi ? 1.0f : __uint_as_float(x1[1])) * G1); \
        float r0 = __builtin_amdgcn_rcpf(qc * T1 * (hi ? 1.0f : __uint_as_float(x0[1])) * G0); \
        float w[16]; \
        _Pragma("unroll") for (int r = 0; r < 8; ++r) { w[r] = e[r] * r0; r0 *= dd[r]; w[8 + r] = e[8 + r] * r1; r1 *= dd[8 + r]; } \
        qc *= T0 * T1; \
        v4u pa0, pa1; \
        pa0.x = pk2(w[0], w[1]); pa0.y = pk2(w[2], w[3]); pa0.z = pk2(w[4], w[5]); pa0.w = pk2(w[6], w[7]); \
        pa1.x = pk2(w[8], w[9]); pa1.y = pk2(w[10], w[11]); pa1.z = pk2(w[12], w[13]); pa1.w = pk2(w[14], w[15]); \
        const bf16x8 P0 = __builtin_bit_cast(bf16x8, pa0), P1 = __builtin_bit_cast(bf16x8, pa1); \
        o0 = __builtin_amdgcn_mfma_f32_32x32x16_bf16(VF[0], P0, o0, 0, 0, 0); \
        o1 = __builtin_amdgcn_mfma_f32_32x32x16_bf16(VF[2], P0, o1, 0, 0, 0); \
        o0 = __builtin_amdgcn_mfma_f32_32x32x16_bf16(VF[1], P1, o0, 0, 0, 0); \
        o1 = __builtin_amdgcn_mfma_f32_32x32x16_bf16(VF[3], P1, o1, 0, 0, 0); \
        LOADV(VF, (jt) - 3); \
    } while (0)
#define DONE(jt) ((jt) == 0 || __ballot(qc <= 8.507059e37f) == 0ull)
    LOADK(ka, qb); LOADV(va, qb); LOADK(kb, qb - 1); LOADV(vb, qb - 1); LOADK(kc, qb - 2); LOADV(vc, qb - 2);
    TILE(ka, va, qb, true);
    if (!DONE(qb)) {
        int j = qb - 1;
        for (;;) {
            TILE(kb, vb, j, false); if (DONE(j)) break; --j;
            TILE(kc, vc, j, false); if (DONE(j)) break; --j;
            TILE(ka, va, j, false); if (DONE(j)) break; --j;
        }
    }
#undef LOADK
#undef LOADV
#undef TILE
#undef DONE
    bf16* Op = CAT + (size_t)(b * SEQ + t0 + r32) * D + h * HD + 4 * hi;
#pragma unroll
    for (int g = 0; g < 4; ++g) {
        v2u w0, w1; w0.x = pk2(o0[4 * g], o0[4 * g + 1]); w0.y = pk2(o0[4 * g + 2], o0[4 * g + 3]); w1.x = pk2(o1[4 * g], o1[4 * g + 1]); w1.y = pk2(o1[4 * g + 2], o1[4 * g + 3]);
        *(v2u*)(Op + 8 * g) = w0; *(v2u*)(Op + 32 + 8 * g) = w1; }
}
__device__ __forceinline__ void p3_mixers(const Params& P, LAS unsigned char* lds, int tid, int lane, int wave, int vb, int mode = 3) {
    const bf16* PROJ = (const bf16*)(P.ws + WS_ACT); const bf16* VT = PROJ; bf16* CAT = (bf16*)(P.ws + WS_CAT);
    const int gw = vb * NWAVES + wave, NGW = gridDim.x * NWAVES;
    constexpr int NQB = SEQ / 32, NUNITS = BATCH * NH * NQB;
    if (mode & 1) {
        LAS unsigned* qctr = (LAS unsigned*)(lds + 131072 + 1024) + ((mode >> 4) & 1);
        bf16* dst = (mode & 16) ? (bf16*)(P.ws + WS_END) : CAT;
        const unsigned per_wg = (unsigned)(NUNITS / (int)gridDim.x);
        for (;;) {
            unsigned i = 0; if (lane == 0) i = __hip_atomic_fetch_add(qctr, 1u, __ATOMIC_RELAXED, __HIP_MEMORY_SCOPE_WORKGROUP);
            i = (unsigned)__builtin_amdgcn_readfirstlane((int)i);
            if (i >= per_wg) break;
            const int lu = (int)(i >> 3) * 256 + (vb & 31) * NWAVES + (int)(i & 7), qb = ((lu & 7) << 3) | ((lu >> 3) & 7), bhl = lu >> 6;
            attn_unit<0>(PROJ, VT, dst, 2 * (vb >> 5) + (bhl >> 3), bhl & 7, qb, lane);
        }
    }
    if (mode & 2) for (int wi = gw; wi < M / 16; wi += NGW) {
        const int m0 = wi * 16, sq0 = m0 & (SEQ - 1), g = lane >> 4, win = 2 << g;
        const bf16* up = PROJ + slab_off(m0 >> 11) + U_OFF + (size_t)sq0 * PW + lane * 8;
        float acc[8];
#pragma unroll
        for (int i = 0; i < 8; ++i) acc[i] = 0.f;
#pragma unroll
        for (int i = 1; i < 16; ++i) { const bool valid = (i < win) && (sq0 - i >= 0); const v4u w = *(const v4u*)(up - (ptrdiff_t)(valid ? i : 0) * PW); const float f = valid ? 1.0f : 0.0f;
            acc[0] += f * bf_lo(w.x); acc[1] += f * bf_hi(w.x); acc[2] += f * bf_lo(w.y); acc[3] += f * bf_hi(w.y); acc[4] += f * bf_lo(w.z); acc[5] += f * bf_hi(w.z); acc[6] += f * bf_lo(w.w); acc[7] += f * bf_hi(w.w); }
#pragma unroll 4
        for (int r = 0; r < 16; ++r) {
            const int sq = sq0 + r, ob = sq - (win - 1); const bool valid = ob >= 0;
            const v4u cur = *(const v4u*)(up + (size_t)r * PW);
            const v4u old = *(const v4u*)(up + (ptrdiff_t)(valid ? r - (win - 1) : r) * PW); const float f = valid ? 1.0f : 0.0f;
            const float c0 = bf_lo(cur.x), c1 = bf_hi(cur.x), c2 = bf_lo(cur.y), c3 = bf_hi(cur.y), c4 = bf_lo(cur.z), c5 = bf_hi(cur.z), c6 = bf_lo(cur.w), c7 = bf_hi(cur.w);
            acc[0] += c0; acc[1] += c1; acc[2] += c2; acc[3] += c3; acc[4] += c4; acc[5] += c5; acc[6] += c6; acc[7] += c7;
            const float inv = 1.0f / (float)((sq + 1 < win) ? sq + 1 : win);
            v4u o; o.x = pk2(acc[0] * inv - c0, acc[1] * inv - c1); o.y = pk2(acc[2] * inv - c2, acc[3] * inv - c3); o.z = pk2(acc[4] * inv - c4, acc[5] * inv - c5); o.w = pk2(acc[6] * inv - c6, acc[7] * inv - c7);
            *(v4u*)(CAT + (size_t)(m0 + r) * D + SBW + lane * 8) = o;
            acc[0] -= f * bf_lo(old.x); acc[1] -= f * bf_hi(old.x); acc[2] -= f * bf_lo(old.y); acc[3] -= f * bf_hi(old.y); acc[4] -= f * bf_lo(old.z); acc[5] -= f * bf_hi(old.z); acc[6] -= f * bf_lo(old.w); acc[7] -= f * bf_hi(old.w);
        }
    }
}

typedef GAS unsigned gu32;
#define XB_TMO      128
#define XB_XCNT(j)  (256  + 64 * (j))
#define XB_XSUB(j)  (1280 + 64 * (j))
#define XB_XGEN(j)  (2304 + 64 * (j))
#define XB_TOP      3328
#define XB_TOPGEN   3392
#define XCD_BAR_WORDS 3456
#define XB_SPIN_CAP (1u << 18)

__device__ __forceinline__ unsigned xb_ld(unsigned* p)              { return __hip_atomic_load(p, __ATOMIC_RELAXED, __HIP_MEMORY_SCOPE_AGENT); }
__device__ __forceinline__ unsigned xb_add(unsigned* p, unsigned v) { return __hip_atomic_fetch_add(p, v, __ATOMIC_RELAXED, __HIP_MEMORY_SCOPE_AGENT); }
__device__ __forceinline__ unsigned xb_xcc_id() { return (unsigned)__builtin_amdgcn_s_getreg((3 << 11) | 20) & 0xFu; }
#define XB_SPIN(cond, bar) do { unsigned _sp = 0; while (cond) { __builtin_amdgcn_s_sleep(1); \
    if ((++_sp & 255u) == 0u) { if (xb_ld(&(bar)[XB_TMO])) break; if (_sp > XB_SPIN_CAP) { atomicAdd(&(bar)[XB_TMO], 1u); break; } } } } while (0)

struct XcdBarrier {
    unsigned* bar; unsigned x;
    volatile LAS unsigned* st;
};

__device__ __forceinline__ XcdBarrier xcd_barrier_post(unsigned* bar, volatile LAS unsigned* st) {
    XcdBarrier b; b.bar = bar; b.x = xb_xcc_id(); b.st = st;
    if (threadIdx.x == 0) (void)xb_add(&bar[XB_XCNT(b.x)], 1u);
    return b;
}
__device__ __forceinline__ void xcd_barrier_complete(unsigned* bar, unsigned x, unsigned& nloc, unsigned& nx) {
    const unsigned G = gridDim.x * gridDim.y * gridDim.z;
    unsigned sum, cnt, mine, sp = 0u;
    for (;;) {
        sum = 0u; cnt = 0u; mine = 0u;
#pragma unroll
        for (unsigned j = 0; j < 16; ++j) { const unsigned c = xb_ld(&bar[XB_XCNT(j)]); sum += c; cnt += (c > 0u) ? 1u : 0u; mine = (j == x) ? c : mine; }
        if (sum == G) break;
        __builtin_amdgcn_s_sleep(1);
        if ((++sp & 255u) == 0u) { if (xb_ld(&bar[XB_TMO])) break; if (sp > XB_SPIN_CAP) { atomicAdd(&bar[XB_TMO], 1u); break; } }
    }
    nloc = mine > 0u ? mine : 1u; nx = cnt > 0u ? cnt : 1u;
}

__device__ __forceinline__ void xcd_barrier(const XcdBarrier& b) {
    asm volatile("s_waitcnt vmcnt(0)" ::: "memory");
    __syncthreads();
    if (threadIdx.x == 0) {
        unsigned* bar = b.bar;
        __builtin_amdgcn_s_waitcnt(0);
        unsigned nloc = b.st[0], nx = b.st[1];
        if (nloc == 0u) { xcd_barrier_complete(bar, b.x, nloc, nx); b.st[0] = nloc; b.st[1] = nx; }
        const unsigned old = xb_add(&bar[XB_XSUB(b.x)], 1u);
        const unsigned gen = old / nloc;
        if (old + 1u == (gen + 1u) * nloc) {
            __builtin_amdgcn_fence(__ATOMIC_RELEASE, "agent");
            asm volatile("s_waitcnt vmcnt(0)" ::: "memory");
            const unsigned og = xb_add(&bar[XB_TOP], 1u);
            const unsigned tg = og / nx;
            if (og + 1u == (tg + 1u) * nx) xb_add(&bar[XB_TOPGEN], 1u);
            else XB_SPIN(xb_ld(&bar[XB_TOPGEN]) == tg, bar);
            __builtin_amdgcn_fence(__ATOMIC_ACQUIRE, "agent");
            xb_add(&bar[XB_XGEN(b.x)], 1u);
            asm volatile("s_waitcnt vmcnt(0)" ::: "memory");
        } else {
            XB_SPIN(xb_ld(&bar[XB_XGEN(b.x)]) == gen, bar);
            __builtin_amdgcn_fence(__ATOMIC_ACQUIRE, "agent");
            asm volatile("s_waitcnt vmcnt(0)" ::: "memory");
        }
    }
    __syncthreads();
}

__device__ __forceinline__ void xcd_local_barrier(unsigned* ctl, unsigned x) {
    asm volatile("s_waitcnt vmcnt(0)" ::: "memory");
    __syncthreads();
    if (threadIdx.x == 0) {
        __builtin_amdgcn_s_waitcnt(0);
        const unsigned old = xb_add(&ctl[5120 + 64 * x], 1u), gen = old / 32u;
        if (old + 1u == (gen + 1u) * 32u) xb_add(&ctl[6144 + 64 * x], 1u);
        else XB_SPIN(xb_ld(&ctl[6144 + 64 * x]) == gen, ctl);
        __builtin_amdgcn_fence(__ATOMIC_ACQUIRE, "agent");
        asm volatile("s_waitcnt vmcnt(0)" ::: "memory");
    }
    __syncthreads();
}

__global__ void __launch_bounds__(NWAVES * 64, 2) hybrid_fwd(Params P) {
    extern __shared__ __attribute__((aligned(16))) unsigned char lds_raw[];
    cg::grid_group grid = cg::this_grid();
    LAS unsigned char* lds = (LAS unsigned char*)lds_raw;
    const int tid = threadIdx.x, lane = tid & 63, wave = __builtin_amdgcn_readfirstlane(tid >> 6);
    const int G = gridDim.x, bx = blockIdx.x;
    bf16* WinT = (bf16*)(P.ws + WS_WIN); bf16* WoT = (bf16*)(P.ws + WS_WO); bf16* WguT = (bf16*)(P.ws + WS_WGU); bf16* WdT = (bf16*)(P.ws + WS_WD);
    bf16* H = (bf16*)(P.ws + WS_H); bf16* MIX = (bf16*)(P.ws + WS_MIX); bf16* CAT = (bf16*)(P.ws + WS_CAT); bf16* ACT = (bf16*)(P.ws + WS_ACT);

    volatile LAS unsigned* bst = (volatile LAS unsigned*)(lds + 131072 + 512);
    if (tid < 2) bst[tid] = 0u;
    if (tid >= 64 && tid < 68) ((volatile LAS unsigned*)(lds + 131072 + 1024))[tid - 64] = 0u;
    __syncthreads();
    const XcdBarrier bar = xcd_barrier_post((unsigned*)(P.ws + WS_CTL), bst);
    if (P.use_cg_sync) grid.sync();
    unsigned* ctl = (unsigned*)(P.ws + WS_CTL);
    volatile LAS unsigned* vinfo = (volatile LAS unsigned*)(lds + 131072 + 1536);
    if (tid == 0) vinfo[0] = xb_add(&ctl[4096 + 64 * bar.x], 1u);
#define GRID_BAR() xcd_barrier(bar)
    p0_prologue(P, lds, tid, lane, wave);
    if (DUP == 1) { __syncthreads(); p0_prologue(P, lds, tid, lane, wave); }
    if (DUP == 11) { __syncthreads(); p0_prologue(P, lds, tid, lane, wave, 1); }
    if (DUP == 12) { __syncthreads(); p0_prologue(P, lds, tid, lane, wave, 2); }
    GRID_BAR();
    if (tid == 0) { bool ok = bar.x < 8u;
        for (unsigned j = 0; j < 16; ++j) ok = ok && (xb_ld(&ctl[XB_XCNT(j)]) == (j < 8u ? 32u : 0u));
        vinfo[1] = ok ? 1u : 0u; }
    __syncthreads();
    const bool xloc = vinfo[1] != 0u;
    const int vb = xloc ? (int)(bar.x * 32u + vinfo[0]) : bx;
    const int vc = xloc ? (int)(vinfo[0] * 8u + bar.x) : bx;
#undef GRID_BAR
#define GRID_BAR() do { if (xloc) xcd_local_barrier(ctl, bar.x); else xcd_barrier(bar); } while (0)
    if (DUP == 50 && xloc && (bar.x & 1u)) { const unsigned long long t0_ = __builtin_amdgcn_s_memrealtime(); while (__builtin_amdgcn_s_memrealtime() - t0_ < 4000ull) __builtin_amdgcn_s_sleep(8); }
    p1_rows(P, lds, tid, lane, wave, vb);
    if (DUP == 2) p1_rows(P, lds, tid, lane, wave, vb);
    GRID_BAR();
    {
        { pg8::Gemm g{H, WinT, M, PROJ_LD, D}; pg8::StaticOrder S; S.init(M, PROJ_LD, G, vc);
          pg8::EpiQKU E{ACT, C2};
          pg8::gemm_phase<pg8::EpiQKU, pg8::StaticOrder, PG8_ALIGN, PG8_SP2>(lds, g, S, E); }
        { pg8::Gemm g{WinT + (size_t)PROJ_LD * D, H, SBW, M, D}; pg8::StaticOrder S; S.init(SBW, M, G, vc);
          pg8::EpiVT E{ACT};
          pg8::gemm_phase<pg8::EpiVT, pg8::StaticOrder, PG8_ALIGN, PG8_SP2>(lds, g, S, E); }
        if (DUP == 20) { pg8::Gemm g{H, WinT, M, PROJ_LD, D}; pg8::StaticOrder S; S.init(M, PROJ_LD, G, vc);
          pg8::EpiQKU E{ACT, C2};
          pg8::gemm_phase<pg8::EpiQKU, pg8::StaticOrder, PG8_ALIGN, PG8_SP2>(lds, g, S, E); }
        if (DUP == 21) { pg8::Gemm g{WinT + (size_t)PROJ_LD * D, H, SBW, M, D}; pg8::StaticOrder S; S.init(SBW, M, G, vc);
          pg8::EpiVT E{ACT};
          pg8::gemm_phase<pg8::EpiVT, pg8::StaticOrder, PG8_ALIGN, PG8_SP2>(lds, g, S, E); }
    }
    GRID_BAR();
    p3_mixers(P, lds, tid, lane, wave, vb);
    if (DUP == 3) p3_mixers(P, lds, tid, lane, wave, vb, 3 + 4);
    if (DUP == 31) p3_mixers(P, lds, tid, lane, wave, vb, 1 + 4);
    if (DUP == 33) p3_mixers(P, lds, tid, lane, wave, vb, 1 + 8);
    if (DUP == 34) p3_mixers(P, lds, tid, lane, wave, vb, 1 + 16);
    if (DUP == 32) p3_mixers(P, lds, tid, lane, wave, vb, 2);
    GRID_BAR();
    {
        pg8::Gemm g{CAT, WoT, M, D, D}; pg8::StaticOrder S; S.init(M, D, G, vc);
        pg8::EpiBf16<0> E{MIX, D, nullptr, 0, 0, 1.f};
        pg8::gemm_phase<pg8::EpiBf16<0>, pg8::StaticOrder, PG8_ALIGN, PG8_SP2>(lds, g, S, E);
        if (DUP == 4) pg8::gemm_phase<pg8::EpiBf16<0>, pg8::StaticOrder, PG8_ALIGN, PG8_SP2>(lds, g, S, E);
    }
    GRID_BAR();
    p5_rows(P, lane, wave, vb);
    if (DUP == 5) p5_rows(P, lane, wave, vb);
    GRID_BAR();
    {
        pg8::Gemm g{H, WguT, M, 2 * DFF, D}; pg8::StaticOrder S; S.init(M, 2 * DFF, G, vc);
        pg8::EpiSwiGLU E{ACT, DFF};
        pg8::gemm_phase<pg8::EpiSwiGLU, pg8::StaticOrder, PG8_ALIGN, PG8_SP2>(lds, g, S, E);
        if (DUP == 6) pg8::gemm_phase<pg8::EpiSwiGLU, pg8::StaticOrder, PG8_ALIGN, PG8_SP2>(lds, g, S, E);
    }
    GRID_BAR();
    {
        pg8::Gemm g{ACT, WdT, M, D, DFF}; pg8::StaticOrder S; S.init(M, D, G, vc);
        pg8::EpiBf16<0> E{MIX, D, nullptr, 0, 0, 1.f};
        pg8::gemm_phase<pg8::EpiBf16<0>, pg8::StaticOrder, PG8_ALIGN, PG8_SP2>(lds, g, S, E);
        if (DUP == 7) pg8::gemm_phase<pg8::EpiBf16<0>, pg8::StaticOrder, PG8_ALIGN, PG8_SP2>(lds, g, S, E);
    }
    GRID_BAR();
    if (DUP == 9) { for (int i = 0; i < 16; ++i) GRID_BAR(); }
    p8_rows(P, lane, wave, vb);
}

extern "C" void kernel_launch(void* const* d_in, const int* in_sizes, int n_in, void* d_out, int out_size, void* d_ws, size_t ws_size, hipStream_t stream) {
    static int grid = 0;
    if (grid == 0) {
        if (n_in != 15 || in_sizes[0] != M * D || out_size != M * D || ws_size < WS_END) { fprintf(stderr, "kernel_launch: unexpected shapes (n_in %d, in0 %d, out %d, ws %zu); nothing launched\n", n_in, n_in > 0 ? in_sizes[0] : -1, out_size, ws_size); grid = -1; return; }
        int dev = 0, cus = 0, per_cu = 0;
        if (hipGetDevice(&dev) != hipSuccess || hipDeviceGetAttribute(&cus, hipDeviceAttributeMultiprocessorCount, dev) != hipSuccess) { grid = -1; return; }
        if (hipFuncSetAttribute((const void*)hybrid_fwd, hipFuncAttributeMaxDynamicSharedMemorySize, LDS_BYTES) != hipSuccess) { fprintf(stderr, "kernel_launch: hipFuncSetAttribute failed\n"); grid = -1; return; }
        if (hipOccupancyMaxActiveBlocksPerMultiprocessor(&per_cu, (const void*)hybrid_fwd, NWAVES * 64, LDS_BYTES) != hipSuccess || per_cu < 1) { fprintf(stderr, "kernel_launch: occupancy query says %d blocks per CU\n", per_cu); per_cu = 1; }
        (void)hipGetLastError();
        grid = cus * per_cu;
        if (grid != 256) { fprintf(stderr, "kernel_launch: built for a 256-workgroup cooperative grid (256 CUs x 1 workgroup), got %d x %d; nothing launched\n", cus, per_cu); grid = -1; return; }
    }
    if (grid < 0) return;
    if (hipMemsetAsync((char*)d_ws + WS_CTL, 0, CTL_BYTES, stream) != hipSuccess) { fprintf(stderr, "kernel_launch: memset of the barrier words failed\n"); return; }
    Params p{};
    p.x = (const float*)d_in[0]; p.c = (const float*)d_in[1]; p.w_cond = (const float*)d_in[2]; p.b_cond = (const float*)d_in[3]; p.g_mix_pre = (const float*)d_in[4]; p.g_mix_post = (const float*)d_in[5];
    p.w_in = (const float*)d_in[6]; p.w_pool = (const float*)d_in[7]; p.pool_scale = (const float*)d_in[8]; p.w_out = (const float*)d_in[9]; p.g_ffn_pre = (const float*)d_in[10]; p.g_ffn_post = (const float*)d_in[11];
    p.w_gate = (const float*)d_in[12]; p.w_up = (const float*)d_in[13]; p.w_down = (const float*)d_in[14];
    p.out = (float*)d_out; p.ws = (unsigned char*)d_ws;
    void* args[] = {&p};
    const hipError_t e = hipLaunchCooperativeKernel((const void*)hybrid_fwd, dim3(grid), dim3(NWAVES * 64), args, LDS_BYTES, stream);
    if (e != hipSuccess) fprintf(stderr, "kernel_launch: cooperative launch failed: %s (grid %d)\n", hipGetErrorString(e), grid);
}
```

```cpp
#include <hip/hip_runtime.h>
#include <hip/hip_cooperative_groups.h>
#include <cstdio>
#include <cstdint>
namespace cg = cooperative_groups;
namespace pg8 {
#define PG8_LAS __attribute__((address_space(3)))
typedef unsigned short bf16_t;
typedef short bf16x8 __attribute__((ext_vector_type(8)));
typedef float f32x4 __attribute__((ext_vector_type(4)));
typedef unsigned u32x4 __attribute__((ext_vector_type(4)));
constexpr int BM = 256, BK = 64, HALF = 128, HTB = HALF * BK * 2  , STAGE_BYTES = 8 * HTB, NXCD = 8, WGM = 8;

__host__ __device__ __forceinline__ int lds_byte(int r, int c) { const int st = (r >> 4) * 2 + (c >> 5), rr = r & 15, cc = c & 31, ob = rr * 64 + cc * 2; return st * 1024 + (ob ^ (((ob >> 9) & 1) << 5)); }
__host__ __device__ __forceinline__ void stage_rc(int b, int& R, int& C) { const int st = b / 1024, sb = b % 1024, swz = sb ^ (((sb >> 9) & 1) << 5); R = (st >> 1) * 16 + swz / 64; C = (st & 1) * 32 + (swz % 64) / 2; }
__host__ __device__ __forceinline__ int perm32(int rho) { const int n = rho >> 4, i = rho & 15; return 8 * (i >> 2) + 4 * n + (i & 3); }

struct Unit { int pm, pn; };
struct Gemm { const bf16_t* A; const bf16_t* Bt; int M, N, K; };

struct StaticOrder {
    int nM, nN, nwg, G, c;
    __host__ __device__ void init(int M, int N, int G_, int c_) { nM = M / BM; nN = N / BM; nwg = nM * nN; G = G_; c = c_; }
    __host__ __device__ bool next(int i, Unit& u) const {
        const long L = (long)i * G + c; if (L >= nwg) return false;
        int wgid = (int)L; { const int q = nwg / NXCD, r = nwg % NXCD, xcd = wgid % NXCD, off = wgid / NXCD; wgid = (xcd < r ? xcd * (q + 1) : r * (q + 1) + (xcd - r) * q) + off; }
        const int nig = WGM * nN, gid = wgid / nig, fm = gid * WGM, gsz = (nM - fm) < WGM ? (nM - fm) : WGM;
        u.pm = fm + ((wgid % nig) % gsz); u.pn = (wgid % nig) / gsz; return true;
    }
    __device__ __forceinline__ void a_ready(const Unit&) const {}
    __device__ __forceinline__ void done(const Unit&) const {}
};

__device__ __forceinline__ unsigned cvt_pk_bf16(float lo, float hi) { unsigned r; asm volatile("v_cvt_pk_bf16_f32 %0, %1, %2" : "=v"(r) : "v"(lo), "v"(hi)); return r; }
typedef float f32x2 __attribute__((ext_vector_type(2)));
__device__ __forceinline__ f32x2 gelu_pk(f32x2 v) {
    const f32x2 av = __builtin_elementwise_abs(v), d = av * 0.2316418882f + 1.0f;
    f32x2 t; t.x = __builtin_amdgcn_rcpf(d.x); t.y = __builtin_amdgcn_rcpf(d.y);
    f32x2 q = t * 0.5307027145f + (-0.7265760135f); q = q * t + 0.7107068705f; q = q * t + (-0.142248368f); q = q * t + 0.127414796f; q = q * t;
    const f32x2 s = (v * v) * (-0.72134752044f);
    f32x2 e; e.x = __builtin_amdgcn_exp2f(s.x); e.y = __builtin_amdgcn_exp2f(s.y);
    const f32x2 m = v * (q * e), r = v - m;
    f32x2 o; o.x = v.x < 0.f ? m.x : r.x; o.y = v.y < 0.f ? m.y : r.y; return o;
}

template <int ACT  > struct EpiBf16 {
    static constexpr bool PERM = true, AFTER_DRAIN = false; static_assert(ACT == 0 || ACT == 1, "EpiBf16: ACT is 0 (none) or 1 (gelu_pk)");
    bf16_t* O; int ldc; const float* bias; int split_cols; size_t split_stride; float scale0;
    __device__ __forceinline__ void operator()(const f32x4 (&acc)[2][2][4][2], const Unit& u, int wr, int wc, int fr, int fq) const {
        const int row0 = u.pm * BM + wr * 64 + fr; int colt = u.pn * BM; bf16_t* base = O;
        float sc = 1.f; if (split_cols) { const int t = colt / split_cols; base += (size_t)t * split_stride; colt -= t * split_cols; if (t == 0) sc = scale0; }
        const int col0 = colt + wc * 32 + 8 * fq, bcol0 = u.pn * BM + wc * 32 + 8 * fq;
        f32x4 bv[2][2];
#pragma unroll
        for (int bj = 0; bj < 2; ++bj)
#pragma unroll
            for (int n = 0; n < 2; ++n) bv[bj][n] = bias ? *(const f32x4*)(bias + bcol0 + bj * HALF + 4 * n) : (f32x4){0.f, 0.f, 0.f, 0.f};
#pragma unroll
        for (int ai = 0; ai < 2; ++ai)
#pragma unroll
            for (int m = 0; m < 4; ++m) { bf16_t* rowp = base + (size_t)(row0 + ai * HALF + m * 16) * ldc + col0;
#pragma unroll
                for (int bj = 0; bj < 2; ++bj) { f32x4 v0 = acc[ai][bj][m][0] + bv[bj][0], v1 = acc[ai][bj][m][1] + bv[bj][1];
                    if (ACT == 1) { f32x2 a = gelu_pk((f32x2){v0[0], v0[1]}), b = gelu_pk((f32x2){v0[2], v0[3]}), c = gelu_pk((f32x2){v1[0], v1[1]}), d = gelu_pk((f32x2){v1[2], v1[3]});
                        v0 = (f32x4){a.x, a.y, b.x, b.y}; v1 = (f32x4){c.x, c.y, d.x, d.y}; }
                    v0 = v0 * sc; v1 = v1 * sc; u32x4 w; w.x = cvt_pk_bf16(v0[0], v0[1]); w.y = cvt_pk_bf16(v0[2], v0[3]); w.z = cvt_pk_bf16(v1[0], v1[1]); w.w = cvt_pk_bf16(v1[2], v1[3]);
                    *(u32x4*)(rowp + bj * HALF) = w; } }
    }
};
struct EpiSwiGLU {
    static constexpr bool PERM = true, AFTER_DRAIN = false;
    bf16_t* O; int ldc;
    __device__ __forceinline__ void operator()(const f32x4 (&acc)[2][2][4][2], const Unit& u, int wr, int wc, int fr, int fq) const {
        const int row0 = u.pm * BM + wr * 64 + fr; const int col0 = u.pn * HALF + wc * 32 + 8 * fq;
#pragma unroll
        for (int ai = 0; ai < 2; ++ai)
#pragma unroll
            for (int m = 0; m < 4; ++m) { bf16_t* rowp = O + (size_t)(row0 + ai * HALF + m * 16) * ldc + col0;
                float r[8];
#pragma unroll
                for (int n = 0; n < 2; ++n)
#pragma unroll
                    for (int j = 0; j < 4; ++j) { const float g = acc[ai][0][m][n][j], up = acc[ai][1][m][n][j];
                        const float e = __builtin_amdgcn_exp2f(g * -1.4426950408889634f); r[n * 4 + j] = g * __builtin_amdgcn_rcpf(1.0f + e) * up; }
                u32x4 w; w.x = cvt_pk_bf16(r[0], r[1]); w.y = cvt_pk_bf16(r[2], r[3]); w.z = cvt_pk_bf16(r[4], r[5]); w.w = cvt_pk_bf16(r[6], r[7]);
                *(u32x4*)rowp = w; }
    }
};

struct EpiQKU {
    static constexpr bool PERM = true, AFTER_DRAIN = false;
    bf16_t* S0; float qscale;
    __device__ __forceinline__ void operator()(const f32x4 (&acc)[2][2][4][2], const Unit& u, int wr, int wc, int fr, int fq) const {
        const int sec = u.pn >> 1, cbase = (u.pn & 1) * BM + wc * 32 + 8 * fq; const float sc = sec == 0 ? qscale : 1.0f;
#pragma unroll
        for (int ai = 0; ai < 2; ++ai)
#pragma unroll
            for (int m = 0; m < 4; ++m) { const int tok = u.pm * BM + ai * HALF + wr * 64 + m * 16 + fr, b = tok >> 11, s = tok & 2047, tile = s >> 5, key = s & 31;
                const int slot = sec == 0 ? key : ((key & ~12) | ((key & 4) << 1) | ((key & 8) >> 1));
#pragma unroll
                for (int bj = 0; bj < 2; ++bj) { const int c = cbase + bj * HALF, h = c >> 6, d = c & 63;
                    bf16_t* sb = S0 + (size_t)(b >> 1) * ((size_t)4096 * 2816) + (size_t)(b & 1) * ((size_t)1 << 20) + (size_t)sec * ((size_t)2 << 20);
                    bf16_t* p = sec == 2 ? sb + (size_t)s * 512 + c
                                         : sb + (((size_t)h * 64 + tile) * 4 + (d >> 4)) * 512 + ((d >> 3) & 1) * 256 + slot * 8;
                    const f32x4 v0 = acc[ai][bj][m][0] * sc, v1 = acc[ai][bj][m][1] * sc;
                    u32x4 w; w.x = cvt_pk_bf16(v0[0], v0[1]); w.y = cvt_pk_bf16(v0[2], v0[3]); w.z = cvt_pk_bf16(v1[0], v1[1]); w.w = cvt_pk_bf16(v1[2], v1[3]);
                    *(u32x4*)p = w; } }
    }
};

struct EpiVT {
    static constexpr bool PERM = true, AFTER_DRAIN = false;
    bf16_t* O;
    __device__ __forceinline__ void operator()(const f32x4 (&acc)[2][2][4][2], const Unit& u, int wr, int wc, int fr, int fq) const {
        const int row0 = u.pm * BM + wr * 64 + fr, col0 = u.pn * BM + wc * 32 + 8 * fq;
#pragma unroll
        for (int ai = 0; ai < 2; ++ai)
#pragma unroll
            for (int m = 0; m < 4; ++m) { const int c = row0 + ai * HALF + m * 16, h = c >> 6, d = c & 63;
#pragma unroll
                for (int bj = 0; bj < 2; ++bj) { const int tok = col0 + bj * HALF, b = tok >> 11, s = tok & 2047;
                    bf16_t* p = O + (size_t)(b >> 1) * ((size_t)4096 * 2816) + (size_t)(b & 1) * ((size_t)1 << 20) + ((size_t)6 << 20) + ((size_t)h * 64 + (s >> 5)) * 2048 + (((d >> 5) * 2 + ((s >> 4) & 1)) * 2 + ((s >> 3) & 1)) * 256 + (d & 31) * 8;
                    const f32x4 v0 = acc[ai][bj][m][0], v1 = acc[ai][bj][m][1];
                    u32x4 w; w.x = cvt_pk_bf16(v0[0], v0[1]); w.y = cvt_pk_bf16(v0[2], v0[3]); w.z = cvt_pk_bf16(v1[0], v1[1]); w.w = cvt_pk_bf16(v1[2], v1[3]);
                    *(u32x4*)p = w; } }
    }
};

template <class Epi, class Sched, bool ALIGN_EPI = false, bool SP2 = false>
__device__ __forceinline__ void gemm_phase(PG8_LAS unsigned char* lds, const Gemm g, const Sched& S, const Epi& E) {
    const int tid = threadIdx.x, wid = __builtin_amdgcn_readfirstlane(tid >> 6), lane = tid & 63, wr = wid >> 2, wc = wid & 3, fr = lane & 15, fq = lane >> 4;
    const int K = g.K, nt = K / BK;
    unsigned voffA[2], voffB[2];
#pragma unroll
    for (int i = 0; i < 2; ++i) { int R, C; stage_rc(tid * 16 + i * 8192, R, C); const int Rb = Epi::PERM ? ((R & ~31) + perm32(R & 31)) : R;
        voffA[i] = (unsigned)(R * K + C) * 2u; voffB[i] = (unsigned)(Rb * K + C) * 2u; }
    const size_t kstep = (size_t)(BK * 2);
    const size_t hstep = (size_t)HALF * K * 2;
    const size_t tstep = 2 * hstep;
    const unsigned ldsw = (unsigned)wid * 1024u;
    const int aoff = lds_byte(wr * 64 + fr, fq * 8), boff = lds_byte(wc * 32 + fr, fq * 8);
#define PG8_SA(b, h) (((b) * 2 + (h)) * HTB)
#define PG8_SB(b, h) ((4 + (b) * 2 + (h)) * HTB)
#define PG8_STAGE(bufoff, gbase, voff) do { _Pragma("unroll") for (int _i = 0; _i < 2; ++_i) \
        __builtin_amdgcn_global_load_lds((const unsigned*)((const char*)(gbase) + (voff)[_i]), (PG8_LAS unsigned*)(lds + (bufoff) + ldsw + _i * 8192), 16, 0, 0); } while (0)
#define PG8_LDA(dst, b, h) do { _Pragma("unroll") for (int m = 0; m < 4; ++m) _Pragma("unroll") for (int k = 0; k < 2; ++k) dst[m][k] = *(const PG8_LAS bf16x8*)(lds + PG8_SA(b, h) + aoff + m * 2048 + k * 1024); } while (0)
#define PG8_LDB(dst, b, h) do { _Pragma("unroll") for (int n = 0; n < 2; ++n) _Pragma("unroll") for (int k = 0; k < 2; ++k) dst[n][k] = *(const PG8_LAS bf16x8*)(lds + PG8_SB(b, h) + boff + n * 2048 + k * 1024); } while (0)
#define PG8_MMA(ai, bj, At, Bt) do { __builtin_amdgcn_s_setprio(1); _Pragma("unroll") for (int m = 0; m < 4; ++m) _Pragma("unroll") for (int n = 0; n < 2; ++n) _Pragma("unroll") for (int k = 0; k < 2; ++k) \
        acc[ai][bj][m][n] = __builtin_amdgcn_mfma_f32_16x16x32_bf16(Bt[n][k], At[m][k], acc[ai][bj][m][n], 0, 0, 0); __builtin_amdgcn_s_setprio(0); } while (0)
#define PG8_WAIT_V(n) asm volatile("s_waitcnt vmcnt(" #n ")" ::: "memory")
#define PG8_WAIT_L(n) asm volatile("s_waitcnt lgkmcnt(" #n ")" ::: "memory")
#define PG8_BAR __builtin_amdgcn_s_barrier()
#define PG8_SCHED __builtin_amdgcn_sched_barrier(0)
    Unit cur, nxt; int ui = 0;
    if (!S.next(0, cur)) return;
    f32x4 acc[2][2][4][2];
#pragma unroll
    for (int a = 0; a < 2; ++a)
#pragma unroll
        for (int b = 0; b < 2; ++b)
#pragma unroll
            for (int m = 0; m < 4; ++m)
#pragma unroll
                for (int n = 0; n < 2; ++n) acc[a][b][m][n] = (f32x4){0.f, 0.f, 0.f, 0.f};
    bf16x8 At[4][2], B0[2][2], B1[2][2];
    const char* cA = (const char*)g.A + (size_t)cur.pm * tstep; const char* cB = (const char*)g.Bt + (size_t)cur.pn * tstep;
    S.a_ready(cur);
    if constexpr (SP2) {
        PG8_STAGE(PG8_SB(0, 0), cB, voffB); PG8_STAGE(PG8_SB(0, 1), cB + hstep, voffB); PG8_STAGE(PG8_SA(0, 0), cA, voffA); PG8_STAGE(PG8_SA(0, 1), cA + hstep, voffA);
        if (wr == 1) PG8_BAR;
        PG8_WAIT_V(2); PG8_BAR;
        PG8_STAGE(PG8_SB(1, 0), cB + kstep, voffB); PG8_STAGE(PG8_SA(1, 0), cA + kstep, voffA); PG8_STAGE(PG8_SB(1, 1), cB + hstep + kstep, voffB);
        PG8_WAIT_V(6); PG8_BAR;
    } else {
        PG8_STAGE(PG8_SB(0, 0), cB, voffB); PG8_STAGE(PG8_SA(0, 0), cA, voffA); PG8_STAGE(PG8_SB(0, 1), cB + hstep, voffB); PG8_STAGE(PG8_SA(0, 1), cA + hstep, voffA);
        if (wr == 1) PG8_BAR;
        PG8_WAIT_V(4); PG8_BAR;
        PG8_STAGE(PG8_SB(1, 0), cB + kstep, voffB); PG8_STAGE(PG8_SA(1, 0), cA + kstep, voffA); PG8_STAGE(PG8_SB(1, 1), cB + hstep + kstep, voffB);
        PG8_WAIT_V(6); PG8_BAR;
    }
    for (;;) {
        const bool has_next = S.next(ui + 1, nxt);
        const char* nA = has_next ? (const char*)g.A + (size_t)nxt.pm * tstep : cA; const char* nB = has_next ? (const char*)g.Bt + (size_t)nxt.pn * tstep : cB;
        for (int t = 0; t < nt; t += 2) {
            const bool last = (t == nt - 2);
            const char* a1 = cA + (size_t)(t + 1) * kstep;
            const char* a2 = last ? nA : cA + (size_t)(t + 2) * kstep; const char* b2 = last ? nB : cB + (size_t)(t + 2) * kstep;
            const char* a3 = a2 + kstep; const char* b3 = b2 + kstep;
            if (last && has_next) S.a_ready(nxt);
            if constexpr (SP2) {
            PG8_LDB(B0, 0, 0); PG8_LDB(B1, 0, 1); PG8_SCHED; PG8_LDA(At, 0, 0); PG8_STAGE(PG8_SA(1, 1), a1 + hstep, voffA);
            PG8_WAIT_V(8); PG8_WAIT_L(0); PG8_BAR; PG8_MMA(0, 0, At, B0); PG8_MMA(0, 1, At, B1); PG8_BAR; PG8_SCHED;
            PG8_LDA(At, 0, 1); PG8_STAGE(PG8_SB(0, 0), b2, voffB); PG8_STAGE(PG8_SB(0, 1), b2 + hstep, voffB); PG8_STAGE(PG8_SA(0, 0), a2, voffA);
            PG8_WAIT_V(8); PG8_WAIT_L(0); PG8_BAR; PG8_MMA(1, 0, At, B0); PG8_MMA(1, 1, At, B1); PG8_BAR; PG8_SCHED;
            PG8_LDB(B0, 1, 0); PG8_LDB(B1, 1, 1); PG8_SCHED; PG8_LDA(At, 1, 0); PG8_STAGE(PG8_SA(0, 1), a2 + hstep, voffA);
            PG8_WAIT_V(8); PG8_WAIT_L(0); PG8_BAR; PG8_MMA(0, 0, At, B0); PG8_MMA(0, 1, At, B1); PG8_BAR; PG8_SCHED;
            PG8_LDA(At, 1, 1); PG8_STAGE(PG8_SB(1, 0), b3, voffB); PG8_STAGE(PG8_SB(1, 1), b3 + hstep, voffB); PG8_STAGE(PG8_SA(1, 0), a3, voffA);
            PG8_WAIT_V(8); PG8_WAIT_L(0); PG8_BAR; PG8_MMA(1, 0, At, B0); PG8_MMA(1, 1, At, B1); PG8_BAR; PG8_SCHED;
            } else {
            PG8_LDB(B0, 0, 0); PG8_SCHED; PG8_LDA(At, 0, 0); PG8_STAGE(PG8_SA(1, 1), a1 + hstep, voffA);
            PG8_WAIT_L(8); PG8_BAR; PG8_WAIT_L(0); PG8_MMA(0, 0, At, B0); PG8_BAR; PG8_SCHED;
            PG8_LDB(B1, 0, 1); PG8_STAGE(PG8_SB(0, 0), b2, voffB);
            PG8_BAR; PG8_WAIT_L(0); PG8_MMA(0, 1, At, B1); PG8_BAR;
            PG8_LDA(At, 0, 1); PG8_STAGE(PG8_SA(0, 0), a2, voffA);
            PG8_BAR; PG8_WAIT_L(0); PG8_MMA(1, 0, At, B0); PG8_BAR; PG8_SCHED;
            PG8_STAGE(PG8_SB(0, 1), b2 + hstep, voffB);
            PG8_WAIT_V(6); PG8_BAR; PG8_MMA(1, 1, At, B1); PG8_BAR;
            PG8_LDB(B0, 1, 0); PG8_SCHED; PG8_LDA(At, 1, 0); PG8_STAGE(PG8_SA(0, 1), a2 + hstep, voffA);
            PG8_WAIT_L(8); PG8_BAR; PG8_WAIT_L(0); PG8_MMA(0, 0, At, B0); PG8_BAR; PG8_SCHED;
            PG8_LDB(B1, 1, 1); PG8_STAGE(PG8_SB(1, 0), b3, voffB);
            PG8_BAR; PG8_WAIT_L(0); PG8_MMA(0, 1, At, B1); PG8_BAR;
            PG8_LDA(At, 1, 1); PG8_STAGE(PG8_SA(1, 0), a3, voffA);
            PG8_BAR; PG8_WAIT_L(0); PG8_MMA(1, 0, At, B0); PG8_BAR; PG8_SCHED;
            PG8_STAGE(PG8_SB(1, 1), b3 + hstep, voffB);
            PG8_WAIT_V(6); PG8_BAR; PG8_MMA(1, 1, At, B1); PG8_BAR;
            }
        }
        if constexpr (ALIGN_EPI) { if (wr == 0) PG8_BAR; }
        if constexpr (!Epi::AFTER_DRAIN) { E(acc, cur, wr, wc, fr, fq); S.done(cur); }
        if (!has_next) break;
#pragma unroll
        for (int a = 0; a < 2; ++a)
#pragma unroll
            for (int b = 0; b < 2; ++b)
#pragma unroll
                for (int m = 0; m < 4; ++m)
#pragma unroll
                    for (int n = 0; n < 2; ++n) acc[a][b][m][n] = (f32x4){0.f, 0.f, 0.f, 0.f};
        cur = nxt; cA = nA; cB = nB; ++ui;
        if constexpr (ALIGN_EPI) { if (wr == 1) PG8_BAR; }
    }
    PG8_WAIT_V(0);
    if constexpr (!ALIGN_EPI) { if (wr == 0) PG8_BAR; }
    PG8_BAR;
    if constexpr (Epi::AFTER_DRAIN) { E.fused(acc, cur, wr, wc, fr, fq, lds, wid, lane); S.done(cur); }
#undef PG8_SA
#undef PG8_SB
#undef PG8_STAGE
#undef PG8_LDA
#undef PG8_LDB
#undef PG8_MMA
#undef PG8_WAIT_V
#undef PG8_WAIT_L
#undef PG8_BAR
#undef PG8_SCHED
}
}

#ifndef PG8_SP2
#define PG8_SP2 true
#endif
#ifndef PG8_ALIGN
#define PG8_ALIGN true
#endif

constexpr int BATCH = 16, SEQ = 2048, D = 1024, M = BATCH * SEQ;
constexpr int NH = 8, HD = 64, SBW = 512, PW = 512, DFF = 2816, NMOD = 6;
constexpr int PROJ_LD = 1536;
constexpr float EPS = 1e-6f;
constexpr float C2 = 0.125f * 1.4426950408889634f;
constexpr int NWAVES = 8;
#ifndef DUP
#define DUP 0
#endif
constexpr size_t MiB = 1u << 20;
constexpr size_t WS_MOD = 0;
constexpr size_t WS_CTL = 512 * 1024, CTL_BYTES = 32768;
constexpr size_t WS_WIN = 1 * MiB;
constexpr size_t WS_WO = 5 * MiB;
constexpr size_t WS_WGU = 7 * MiB;
constexpr size_t WS_WD = 18 * MiB;
constexpr size_t WS_H = 24 * MiB;
constexpr size_t WS_MIX = 88 * MiB;
constexpr size_t WS_ACT = 152 * MiB;
constexpr size_t SLAB_E = (size_t)4096 * DFF;
constexpr size_t Q_OFF = 0, K_OFF = (size_t)2 << 20, U_OFF = (size_t)4 << 20, V_OFF = (size_t)6 << 20;
constexpr size_t WS_CAT = 328 * MiB;
constexpr size_t WS_X1 = 392 * MiB;
constexpr size_t WS_XB = 456 * MiB;
constexpr size_t WS_PART = 457 * MiB;
constexpr size_t WS_END = 464 * MiB;
static_assert(V_OFF + ((size_t)2 << 20) <= SLAB_E, "slab sections");
static_assert(WS_ACT + (size_t)M * DFF * 2 <= WS_END, "ws map");
constexpr int LDS_BYTES = 147456;

#define GAS __attribute__((address_space(1)))
#define LAS __attribute__((address_space(3)))
typedef unsigned short bf16;
typedef unsigned v4u __attribute__((ext_vector_type(4)));
typedef unsigned v2u __attribute__((ext_vector_type(2)));
typedef float f32x4 __attribute__((ext_vector_type(4)));
typedef float f32x16 __attribute__((ext_vector_type(16)));
typedef short bf16x8 __attribute__((ext_vector_type(8)));
typedef float f32x2_t __attribute__((ext_vector_type(2))); typedef __bf16 bf16x2_t __attribute__((ext_vector_type(2)));
__device__ __forceinline__ unsigned pk2(float lo, float hi) { f32x2_t v = {lo, hi}; bf16x2_t b = __builtin_convertvector(v, bf16x2_t); return __builtin_bit_cast(unsigned, b); }
__device__ __forceinline__ float bf_lo(unsigned w) { return __uint_as_float(w << 16); }
__device__ __forceinline__ float bf_hi(unsigned w) { return __uint_as_float(w & 0xffff0000u); }
__device__ __forceinline__ float wave_sum(float v) {
#pragma unroll
    for (int o = 1; o < 64; o <<= 1) v += __shfl_xor(v, o);
    return v;
}

__host__ __device__ __forceinline__ size_t slab_off(int b) { return (size_t)(b >> 1) * SLAB_E + (size_t)(b & 1) * ((size_t)1 << 20); }

struct Params {
    const float *x, *c, *w_cond, *b_cond, *g_mix_pre, *g_mix_post, *w_in, *w_pool, *pool_scale, *w_out, *g_ffn_pre, *g_ffn_post, *w_gate, *w_up, *w_down;
    float* out; unsigned char* ws; int use_cg_sync; int pad;
};

__device__ __forceinline__ void transpose_item(const float* W, int ldw, bf16* WT, int ldt, int k0, int n0, int drow0, LAS float* scr, int lane) {
#pragma unroll
    for (int i = 0; i < 32; ++i) { const int kk = 2 * i + (lane >> 5); scr[kk * 33 + (lane & 31)] = __builtin_nontemporal_load(W + (size_t)(k0 + kk) * ldw + n0 + (lane & 31)); }
    asm volatile("s_waitcnt lgkmcnt(0)" ::: "memory");
    const int c = lane & 7;
#pragma unroll
    for (int j = 0; j < 4; ++j) { const int n = (lane >> 3) + 8 * j; const LAS float* s = scr + (8 * c) * 33 + n;
        v4u o; o.x = pk2(s[0 * 33], s[1 * 33]); o.y = pk2(s[2 * 33], s[3 * 33]); o.z = pk2(s[4 * 33], s[5 * 33]); o.w = pk2(s[6 * 33], s[7 * 33]);
        *(v4u*)(WT + (size_t)(drow0 + n) * ldt + k0 + 8 * c) = o; }
    asm volatile("s_waitcnt lgkmcnt(0)" ::: "memory");
}

__device__ __forceinline__ void p0_prologue(const Params& P, LAS unsigned char* lds, int tid, int lane, int wave, int mode = 3) {
    LAS float* sc = (LAS float*)lds;
    LAS float* red = (LAS float*)(lds + 4096);
    float* part = (float*)(P.ws + WS_PART);
    const int item = blockIdx.x, kc = item >> 4, cc = item & 15, cg4 = tid % 96, ks = tid / 96; const bool do_mod = (mode & 1) && item < 256;
    f32x4 wv[13];
    {   const float* wp = P.w_cond + (size_t)(64 * kc + ks) * (NMOD * D) + 384 * cc + 4 * cg4;
#pragma unroll
        for (int i = 0; i < 13; ++i) wv[i] = (do_mod && tid < 480 && ks + 5 * i < 64) ? __builtin_nontemporal_load((const f32x4*)(wp + (size_t)(5 * i) * (NMOD * D))) : (f32x4){0.f, 0.f, 0.f, 0.f}; }
    LAS float* scr = (LAS float*)(lds + wave * 16384);
    const int gw = blockIdx.x * NWAVES + wave, NGW = gridDim.x * NWAVES;
    bf16* WinT = (bf16*)(P.ws + WS_WIN); bf16* WoT = (bf16*)(P.ws + WS_WO); bf16* WguT = (bf16*)(P.ws + WS_WGU); bf16* WdT = (bf16*)(P.ws + WS_WD);
    constexpr int I_IN = 16 * 64, I_O = 8 * 32, I_G = 16 * 88, I_D = 44 * 32, I_E = 16 * 64;
    constexpr int NITEMS = I_IN + I_O + 2 * I_G + I_D + I_E;
    if ((mode & 2) && blockIdx.x < 128) {
        const int bi = blockIdx.x, kb64 = bi >> 4, g = kb64 >> 1, kl0 = (kb64 & 1) * 64, n0 = (bi & 15) * 64;
        LAS float* Bt = (LAS float*)lds;
        LAS float* At = (LAS float*)(lds + 32768);
        float bv[16], av[16];
#pragma unroll
        for (int j = 0; j < 16; ++j) { const int idx = tid + 512 * j; bv[j] = P.w_out[(size_t)(512 + g * 128 + (idx >> 6)) * 1024 + n0 + (idx & 63)];
            av[j] = P.w_pool[(size_t)g * 128 * 128 + (size_t)(kl0 + (idx >> 7)) * 128 + (idx & 127)] * P.pool_scale[g * 128 + (idx & 127)]; }
#pragma unroll
        for (int j = 0; j < 16; ++j) { const int idx = tid + 512 * j; Bt[idx] = bv[j]; At[idx] = av[j]; }
        __syncthreads();
        float acc[8];
#pragma unroll
        for (int i = 0; i < 8; ++i) acc[i] = 0.f;
#pragma unroll 4
        for (int cq = 0; cq < 32; ++cq) {
            float b4[4];
#pragma unroll
            for (int t = 0; t < 4; ++t) b4[t] = Bt[(4 * cq + t) * 64 + lane];
#pragma unroll
            for (int i = 0; i < 8; ++i) { const f32x4 a = *(const LAS f32x4*)(At + (8 * wave + i) * 128 + 4 * cq); acc[i] += (a[0] * b4[0] + a[1] * b4[1]) + (a[2] * b4[2] + a[3] * b4[3]); } }
        v4u o; o.x = pk2(acc[0], acc[1]); o.y = pk2(acc[2], acc[3]); o.z = pk2(acc[4], acc[5]); o.w = pk2(acc[6], acc[7]);
        *(v4u*)(WoT + (size_t)(n0 + lane) * 1024 + 512 + g * 128 + kl0 + 8 * wave) = o;
        __syncthreads();
    }
    if (mode & 2) for (int it = gw; it < NITEMS - I_E; it += NGW) {
        int r = it;
        if (r < I_IN) { const int kb = r >> 6, nb = r & 63, n0 = nb * 32; const int sec = n0 >> 9;
            const int drow = (sec == 2) ? 1536 + (n0 - 1024) : (sec == 3) ? 1024 + (n0 - 1536) : n0;
            transpose_item(P.w_in, 2048, WinT, 1024, kb * 64, n0, drow, scr, lane); continue; } r -= I_IN;
        if (r < I_O) { const int kb = r >> 5, nb = r & 31; transpose_item(P.w_out, 1024, WoT, 1024, kb * 64, nb * 32, nb * 32, scr, lane); continue; } r -= I_O;
        if (r < I_G) { const int kb = r / 88, nb = r % 88, n0 = nb * 32; transpose_item(P.w_gate, DFF, WguT, 1024, kb * 64, n0, (n0 >> 7) * 256 + (n0 & 127), scr, lane); continue; } r -= I_G;
        if (r < I_G) { const int kb = r / 88, nb = r % 88, n0 = nb * 32; transpose_item(P.w_up, DFF, WguT, 1024, kb * 64, n0, (n0 >> 7) * 256 + 128 + (n0 & 127), scr, lane); continue; } r -= I_G;
        if (r < I_D) { const int kb = r >> 5, nb = r & 31; transpose_item(P.w_down, 1024, WdT, DFF, kb * 64, nb * 32, nb * 32, scr, lane); continue; } r -= I_D;
    }
    if (do_mod) {
        __syncthreads();
        for (int i = tid; i < 1024; i += NWAVES * 64) { const int b = i >> 6, kk = i & 63; const float v = P.c[b * D + 64 * kc + kk]; sc[kk * 16 + b] = v / (1.0f + __expf(-v)); }
        __syncthreads();
        if (tid < 480) {
            f32x4 acc[16];
#pragma unroll
            for (int b = 0; b < 16; ++b) acc[b] = (f32x4){0.f, 0.f, 0.f, 0.f};
#pragma unroll
            for (int i = 0; i < 13; ++i) { const int kk = (ks + 5 * i < 64) ? ks + 5 * i : 63; const LAS f32x4* s4 = (const LAS f32x4*)(sc + kk * 16);
#pragma unroll
                for (int q = 0; q < 4; ++q) { const f32x4 s = s4[q]; acc[4 * q + 0] += wv[i] * s[0]; acc[4 * q + 1] += wv[i] * s[1]; acc[4 * q + 2] += wv[i] * s[2]; acc[4 * q + 3] += wv[i] * s[3]; } }
#pragma unroll
            for (int b = 0; b < 16; ++b) *(LAS f32x4*)(red + (ks * 16 + b) * 384 + 4 * cg4) = acc[b];
        }
        __syncthreads();
        for (int idx = tid; idx < 16 * 384; idx += NWAVES * 64) { const int b = idx / 384, col = idx % 384; float s = 0.f;
#pragma unroll
            for (int ks2 = 0; ks2 < 5; ++ks2) s += red[(ks2 * 16 + b) * 384 + col];
            part[((size_t)kc * 16 + b) * (NMOD * D) + 384 * cc + col] = s; }
        __syncthreads();
    }
}

__device__ __forceinline__ f32x4 unpack_bf4(v2u w) { return (f32x4){bf_lo(w.x), bf_hi(w.x), bf_lo(w.y), bf_hi(w.y)}; }
__device__ __forceinline__ float sumsq4(const f32x4 (&v)[4]) { float ss = 0.f;
#pragma unroll
    for (int j = 0; j < 4; ++j) ss += (v[j][0] * v[j][0] + v[j][1] * v[j][1]) + (v[j][2] * v[j][2] + v[j][3] * v[j][3]);
    return ss; }
constexpr int NPF = 3;
__device__ __forceinline__ void p1_rows(const Params& P, LAS unsigned char* lds, int tid, int lane, int wave, int vb) {
    const int gw = vb * NWAVES + wave, NGW = gridDim.x * NWAVES;
    float* mod = (float*)(P.ws + WS_MOD); bf16* H = (bf16*)(P.ws + WS_H); const float* part = (const float*)(P.ws + WS_PART);
    LAS float* ms = (LAS float*)lds;
    for (int ch = gw; ch < M / 16; ch += NGW) {
        const int r0 = ch * 16, b = r0 / SEQ;
        const f32x4* xb = (const f32x4*)(P.x + (size_t)r0 * D) + lane;
        f32x4 ring[NPF + 1][4];
#pragma unroll
        for (int r = 0; r < NPF; ++r)
#pragma unroll
            for (int j = 0; j < 4; ++j) ring[r][j] = __builtin_nontemporal_load(xb + (size_t)r * (D / 4) + 64 * j);
        {
            const int sub = ((ch - wave) / NWAVES) & 15;
            float sv[5]; int cols[5];
#pragma unroll
            for (int j = 0; j < 5; ++j) { cols[j] = j < 4 ? tid + 512 * j : 2048 + 256 * sub + (tid & 255); sv[j] = P.b_cond[cols[j]]; }
#pragma unroll 4
            for (int kc = 0; kc < 16; ++kc) { const float* pp = part + ((size_t)kc * 16 + b) * (NMOD * D);
#pragma unroll
                for (int j = 0; j < 5; ++j) sv[j] += pp[cols[j]]; }
            __syncthreads();
#pragma unroll
            for (int j = 0; j < 4; ++j) ms[cols[j]] = sv[j];
            if (tid < 256) mod[(size_t)b * (NMOD * D) + cols[4]] = sv[4];
            __syncthreads();
        }
        f32x4 a[4], sh[4];
#pragma unroll
        for (int j = 0; j < 4; ++j) { const int c0 = 4 * lane + 256 * j; const f32x4 g = *(const f32x4*)(P.g_mix_pre + c0), scl = *(const LAS f32x4*)(ms + D + c0); a[j] = g * (scl + 1.0f); sh[j] = *(const LAS f32x4*)(ms + c0); }
#pragma unroll 1
        for (int rb = 0; rb < 16; rb += NPF + 1)
#pragma unroll
        for (int rk = 0; rk < NPF + 1; ++rk) { const int r = rb + rk;
            if (r + NPF < 16) {
#pragma unroll
                for (int j = 0; j < 4; ++j) ring[(rk + NPF) % (NPF + 1)][j] = __builtin_nontemporal_load(xb + (size_t)(r + NPF) * (D / 4) + 64 * j); }
            const f32x4 (&v)[4] = ring[rk];
            const float rstd = 1.0f / sqrtf(wave_sum(sumsq4(v)) * (1.0f / D) + EPS);
            v2u* o8 = (v2u*)(H + (size_t)(r0 + r) * D) + lane;
#pragma unroll
            for (int j = 0; j < 4; ++j) { const f32x4 y = v[j] * rstd * a[j] + sh[j]; v2u w; w.x = pk2(y[0], y[1]); w.y = pk2(y[2], y[3]); o8[64 * j] = w; }
        }
    }
}
__device__ __forceinline__ void p5_rows(const Params& P, int lane, int wave, int vb) {
    const int gw = vb * NWAVES + wave, NGW = gridDim.x * NWAVES;
    const float* mod = (const float*)(P.ws + WS_MOD); bf16* H = (bf16*)(P.ws + WS_H); const bf16* MIX = (const bf16*)(P.ws + WS_MIX);
    for (int ch = gw; ch < M / 16; ch += NGW) {
        const int r0 = ch * 16, b = r0 / SEQ; const float* mb = mod + (size_t)b * (NMOD * D);
        const f32x4* xb = (const f32x4*)(P.x + (size_t)r0 * D) + lane; const v2u* mbp = (const v2u*)(MIX + (size_t)r0 * D) + lane;
        f32x4 rx[NPF + 1][4]; v2u rm[NPF + 1][4];
#pragma unroll
        for (int r = 0; r < NPF; ++r)
#pragma unroll
            for (int j = 0; j < 4; ++j) { rm[r][j] = __builtin_nontemporal_load(mbp + (size_t)r * (D / 4) + 64 * j); rx[r][j] = __builtin_nontemporal_load(xb + (size_t)r * (D / 4) + 64 * j); }
        f32x4 gm[4], a[4], sh[4];
#pragma unroll
        for (int j = 0; j < 4; ++j) { const int c0 = 4 * lane + 256 * j;
            gm[j] = *(const f32x4*)(mb + 2 * D + c0) * *(const f32x4*)(P.g_mix_post + c0);
            a[j] = *(const f32x4*)(P.g_ffn_pre + c0) * (*(const f32x4*)(mb + 4 * D + c0) + 1.0f); sh[j] = *(const f32x4*)(mb + 3 * D + c0); }
#pragma unroll 1
        for (int rb = 0; rb < 16; rb += NPF + 1)
#pragma unroll
        for (int rk = 0; rk < NPF + 1; ++rk) { const int r = rb + rk;
            if (r + NPF < 16) {
#pragma unroll
                for (int j = 0; j < 4; ++j) { rm[(rk + NPF) % (NPF + 1)][j] = __builtin_nontemporal_load(mbp + (size_t)(r + NPF) * (D / 4) + 64 * j); rx[(rk + NPF) % (NPF + 1)][j] = __builtin_nontemporal_load(xb + (size_t)(r + NPF) * (D / 4) + 64 * j); } }
            const size_t row = (size_t)(r0 + r);
            f32x4 mv[4], xv[4];
#pragma unroll
            for (int j = 0; j < 4; ++j) { mv[j] = unpack_bf4(rm[rk][j]); xv[j] = rx[rk][j]; }
            const float rstd = 1.0f / sqrtf(wave_sum(sumsq4(mv)) * (1.0f / D) + EPS);
#pragma unroll
            for (int j = 0; j < 4; ++j) xv[j] = xv[j] + gm[j] * (mv[j] * rstd);
            const float rstd2 = 1.0f / sqrtf(wave_sum(sumsq4(xv)) * (1.0f / D) + EPS);
            v2u* x8 = (v2u*)((bf16*)(P.ws + WS_X1) + row * D) + lane; v2u* o8 = (v2u*)(H + row * D) + lane;
#pragma unroll
            for (int j = 0; j < 4; ++j) { v2u xw; xw.x = pk2(xv[j][0], xv[j][1]); xw.y = pk2(xv[j][2], xv[j][3]); __builtin_nontemporal_store(xw, x8 + 64 * j);
                const f32x4 y = xv[j] * rstd2 * a[j] + sh[j]; v2u w; w.x = pk2(y[0], y[1]); w.y = pk2(y[2], y[3]); o8[64 * j] = w; }
        }
    }
}
__device__ __forceinline__ void p8_rows(const Params& P, int lane, int wave, int vb) {
    const int gw = vb * NWAVES + wave, NGW = gridDim.x * NWAVES;
    const float* mod = (const float*)(P.ws + WS_MOD); const bf16* FB = (const bf16*)(P.ws + WS_MIX); const bf16* X1 = (const bf16*)(P.ws + WS_X1);
    for (int ch = gw; ch < M / 16; ch += NGW) {
        const int r0 = ch * 16, b = r0 / SEQ; const float* mb = mod + (size_t)b * (NMOD * D);
        f32x4* ob = (f32x4*)(P.out + (size_t)r0 * D) + lane; const v2u* fbp = (const v2u*)(FB + (size_t)r0 * D) + lane; const v2u* xbp = (const v2u*)(X1 + (size_t)r0 * D) + lane;
        v2u rx[NPF + 1][4], rf[NPF + 1][4];
#pragma unroll
        for (int r = 0; r < NPF; ++r)
#pragma unroll
            for (int j = 0; j < 4; ++j) { rf[r][j] = __builtin_nontemporal_load(fbp + (size_t)r * (D / 4) + 64 * j); rx[r][j] = __builtin_nontemporal_load(xbp + (size_t)r * (D / 4) + 64 * j); }
        f32x4 gf[4];
#pragma unroll
        for (int j = 0; j < 4; ++j) { const int c0 = 4 * lane + 256 * j; gf[j] = *(const f32x4*)(mb + 5 * D + c0) * *(const f32x4*)(P.g_ffn_post + c0); }
#pragma unroll 1
        for (int rb = 0; rb < 16; rb += NPF + 1)
#pragma unroll
        for (int rk = 0; rk < NPF + 1; ++rk) { const int r = rb + rk;
            if (r + NPF < 16) {
#pragma unroll
                for (int j = 0; j < 4; ++j) { rf[(rk + NPF) % (NPF + 1)][j] = __builtin_nontemporal_load(fbp + (size_t)(r + NPF) * (D / 4) + 64 * j); rx[(rk + NPF) % (NPF + 1)][j] = __builtin_nontemporal_load(xbp + (size_t)(r + NPF) * (D / 4) + 64 * j); } }
            f32x4 fv[4];
#pragma unroll
            for (int j = 0; j < 4; ++j) fv[j] = unpack_bf4(rf[rk][j]);
            const float rstd = 1.0f / sqrtf(wave_sum(sumsq4(fv)) * (1.0f / D) + EPS);
#pragma unroll
            for (int j = 0; j < 4; ++j) __builtin_nontemporal_store(unpack_bf4(rx[rk][j]) + gf[j] * (fv[j] * rstd), ob + (size_t)r * (D / 4) + 64 * j);
        }
    }
}

template <int VAR> __device__ __forceinline__ void attn_unit(const bf16* PROJ, const bf16* VT, bf16* CAT, int b, int h, int qb, int lane) {
    const int r32 = lane & 31, hi = lane >> 5, t0 = qb * 32;
    const bf16* Qp = PROJ + slab_off(b) + Q_OFF + ((size_t)h * 64 + qb) * 2048 + lane * 8;
    bf16x8 qf[4];
#pragma unroll
    for (int d0 = 0; d0 < 4; ++d0) qf[d0] = *(const bf16x8*)(Qp + d0 * 512);
    const bf16* Kp = PROJ + slab_off(b) + K_OFF + (size_t)h * (SEQ * HD) + lane * 8;
    const bf16* Vp = VT + slab_off(b) + V_OFF + (size_t)h * (SEQ * HD) + lane * 8;
    f32x16 o0 = {}, o1 = {};
    float qc = 1.0f;
    bf16x8 ka[4], va[4], kb[4], vb[4], kc[4], vc[4];
#define LOADK(KF, jt) do { const int jt_ = (jt) > 0 ? (jt) : 0; const bf16* kp_ = Kp + jt_ * 2048; \
        _Pragma("unroll") for (int d0 = 0; d0 < 4; ++d0) KF[d0] = *(const bf16x8*)(kp_ + d0 * 512); } while (0)
#define LOADV(VF, jt) do { const int jt_ = (jt) > 0 ? (jt) : 0; const bf16* vp_ = Vp + jt_ * 2048; \
        VF[0] = *(const bf16x8*)(vp_); VF[1] = *(const bf16x8*)(vp_ + 512); VF[2] = *(const bf16x8*)(vp_ + 1024); VF[3] = *(const bf16x8*)(vp_ + 1536); } while (0)
#define TILE(KF, VF, jt, DIAG) do { \
        f32x16 s = {}; \
        _Pragma("unroll") for (int d0 = 0; d0 < 4; ++d0) s = __builtin_amdgcn_mfma_f32_32x32x16_bf16(KF[d0], qf[d0], s, 0, 0, 0); \
        LOADK(KF, (jt) - 3); \
        float e[16], dd[16]; \
        _Pragma("unroll") for (int r = 0; r < 16; ++r) { e[r] = __builtin_amdgcn_exp2f(__builtin_fminf(s[r], 120.0f)); dd[r] = 1.0f + e[r]; }     \
        if (DIAG) {                                                            \
            _Pragma("unroll") for (int r = 0; r < 16; ++r) { const int kk = 8 * hi + (r & 7) + 16 * (r >> 3); if (kk >= r32) { e[r] = 0.0f; dd[r] = 1.0f; } } } \
        const float G0 = ((dd[0] * dd[1]) * (dd[2] * dd[3])) * ((dd[4] * dd[5]) * (dd[6] * dd[7])); \
        const float G1 = ((dd[8] * dd[9]) * (dd[10] * dd[11])) * ((dd[12] * dd[13]) * (dd[14] * dd[15])); \
        const auto x0 = __builtin_amdgcn_permlane32_swap(__float_as_uint(G0), __float_as_uint(G0), false, false);     \
        const auto x1 = __builtin_amdgcn_permlane32_swap(__float_as_uint(G1), __float_as_uint(G1), false, false); \
        const float T0 = __uint_as_float(x0[0]) * __uint_as_float(x0[1]), T1 = __uint_as_float(x1[0]) * __uint_as_float(x1[1]); \
          \
        float r1 = __builtin_amdgcn_rcpf(qc * (hi ? 1.0f : __uint_as_float(x1[1])) * G1); \
        float r0 = __builtin_amdgcn_rcpf(qc * T1 * (hi ? 1.0f : __uint_as_float(x0[1])) * G0); \
        float w[16]; \
        _Pragma("unroll") for (int r = 0; r < 8; ++r) { w[r] = e[r] * r0; r0 *= dd[r]; w[8 + r] = e[8 + r] * r1; r1 *= dd[8 + r]; } \
        qc *= T0 * T1; \
        v4u pa0, pa1; \
        pa0.x = pk2(w[0], w[1]); pa0.y = pk2(w[2], w[3]); pa0.z = pk2(w[4], w[5]); pa0.w = pk2(w[6], w[7]); \
        pa1.x = pk2(w[8], w[9]); pa1.y = pk2(w[10], w[11]); pa1.z = pk2(w[12], w[13]); pa1.w = pk2(w[14], w[15]); \
        const bf16x8 P0 = __builtin_bit_cast(bf16x8, pa0), P1 = __builtin_bit_cast(bf16x8, pa1); \
        o0 = __builtin_amdgcn_mfma_f32_32x32x16_bf16(VF[0], P0, o0, 0, 0, 0); \
        o1 = __builtin_amdgcn_mfma_f32_32x32x16_bf16(VF[2], P0, o1, 0, 0, 0); \
        o0 = __builtin_amdgcn_mfma_f32_32x32x16_bf16(VF[1], P1, o0, 0, 0, 0); \
        o1 = __builtin_amdgcn_mfma_f32_32x32x16_bf16(VF[3], P1, o1, 0, 0, 0); \
        LOADV(VF, (jt) - 3); \
    } while (0)
#define DONE(jt) ((jt) == 0 || __ballot(qc <= 8.507059e37f) == 0ull)
    LOADK(ka, qb); LOADV(va, qb); LOADK(kb, qb - 1); LOADV(vb, qb - 1); LOADK(kc, qb - 2); LOADV(vc, qb - 2);
    TILE(ka, va, qb, true);
    if (!DONE(qb)) {
        int j = qb - 1;
        for (;;) {
            TILE(kb, vb, j, false); if (DONE(j)) break; --j;
            TILE(kc, vc, j, false); if (DONE(j)) break; --j;
            TILE(ka, va, j, false); if (DONE(j)) break; --j;
        }
    }
#undef LOADK
#undef LOADV
#undef TILE
#undef DONE
    bf16* Op = CAT + (size_t)(b * SEQ + t0 + r32) * D + h * HD + 4 * hi;
#pragma unroll
    for (int g = 0; g < 4; ++g) {
        v2u w0, w1; w0.x = pk2(o0[4 * g], o0[4 * g + 1]); w0.y = pk2(o0[4 * g + 2], o0[4 * g + 3]); w1.x = pk2(o1[4 * g], o1[4 * g + 1]); w1.y = pk2(o1[4 * g + 2], o1[4 * g + 3]);
        *(v2u*)(Op + 8 * g) = w0; *(v2u*)(Op + 32 + 8 * g) = w1; }
}
__device__ __forceinline__ void p3_mixers(const Params& P, LAS unsigned char* lds, int tid, int lane, int wave, int vb, int mode = 3) {
    const bf16* PROJ = (const bf16*)(P.ws + WS_ACT); const bf16* VT = PROJ; bf16* CAT = (bf16*)(P.ws + WS_CAT);
    const int gw = vb * NWAVES + wave, NGW = gridDim.x * NWAVES;
    constexpr int NQB = SEQ / 32, NUNITS = BATCH * NH * NQB;
    if (mode & 1) {
        LAS unsigned* qctr = (LAS unsigned*)(lds + 131072 + 1024) + ((mode >> 4) & 1);
        bf16* dst = (mode & 16) ? (bf16*)(P.ws + WS_END) : CAT;
        const unsigned per_wg = (unsigned)(NUNITS / (int)gridDim.x);
        for (;;) {
            unsigned i = 0; if (lane == 0) i = __hip_atomic_fetch_add(qctr, 1u, __ATOMIC_RELAXED, __HIP_MEMORY_SCOPE_WORKGROUP);
            i = (unsigned)__builtin_amdgcn_readfirstlane((int)i);
            if (i >= per_wg) break;
            const int lu = (int)(i >> 3) * 256 + (vb & 31) * NWAVES + (int)(i & 7), qb = ((lu & 7) << 3) | ((lu >> 3) & 7), bhl = lu >> 6;
            attn_unit<0>(PROJ, VT, dst, 2 * (vb >> 5) + (bhl >> 3), bhl & 7, qb, lane);
        }
    }
    if (mode & 2) for (int wi = gw; wi < M / 16; wi += NGW) {
        const int m0 = wi * 16, sq0 = m0 & (SEQ - 1), g = lane >> 4, win = 2 << g;
        const bf16* up = PROJ + slab_off(m0 >> 11) + U_OFF + (size_t)sq0 * PW + lane * 8;
        float acc[8];
#pragma unroll
        for (int i = 0; i < 8; ++i) acc[i] = 0.f;
#pragma unroll
        for (int i = 1; i < 16; ++i) { const bool valid = (i < win) && (sq0 - i >= 0); const v4u w = *(const v4u*)(up - (ptrdiff_t)(valid ? i : 0) * PW); const float f = valid ? 1.0f : 0.0f;
            acc[0] += f * bf_lo(w.x); acc[1] += f * bf_hi(w.x); acc[2] += f * bf_lo(w.y); acc[3] += f * bf_hi(w.y); acc[4] += f * bf_lo(w.z); acc[5] += f * bf_hi(w.z); acc[6] += f * bf_lo(w.w); acc[7] += f * bf_hi(w.w); }
#pragma unroll 4
        for (int r = 0; r < 16; ++r) {
            const int sq = sq0 + r, ob = sq - (win - 1); const bool valid = ob >= 0;
            const v4u cur = *(const v4u*)(up + (size_t)r * PW);
            const v4u old = *(const v4u*)(up + (ptrdiff_t)(valid ? r - (win - 1) : r) * PW); const float f = valid ? 1.0f : 0.0f;
            const float c0 = bf_lo(cur.x), c1 = bf_hi(cur.x), c2 = bf_lo(cur.y), c3 = bf_hi(cur.y), c4 = bf_lo(cur.z), c5 = bf_hi(cur.z), c6 = bf_lo(cur.w), c7 = bf_hi(cur.w);
            acc[0] += c0; acc[1] += c1; acc[2] += c2; acc[3] += c3; acc[4] += c4; acc[5] += c5; acc[6] += c6; acc[7] += c7;
            const float inv = 1.0f / (float)((sq + 1 < win) ? sq + 1 : win);
            v4u o; o.x = pk2(acc[0] * inv - c0, acc[1] * inv - c1); o.y = pk2(acc[2] * inv - c2, acc[3] * inv - c3); o.z = pk2(acc[4] * inv - c4, acc[5] * inv - c5); o.w = pk2(acc[6] * inv - c6, acc[7] * inv - c7);
            *(v4u*)(CAT + (size_t)(m0 + r) * D + SBW + lane * 8) = o;
            acc[0] -= f * bf_lo(old.x); acc[1] -= f * bf_hi(old.x); acc[2] -= f * bf_lo(old.y); acc[3] -= f * bf_hi(old.y); acc[4] -= f * bf_lo(old.z); acc[5] -= f * bf_hi(old.z); acc[6] -= f * bf_lo(old.w); acc[7] -= f * bf_hi(old.w);
        }
    }
}

typedef GAS unsigned gu32;
#define XB_TMO      128
#define XB_XCNT(j)  (256  + 64 * (j))
#define XB_XSUB(j)  (1280 + 64 * (j))
#define XB_XGEN(j)  (2304 + 64 * (j))
#define XB_TOP      3328
#define XB_TOPGEN   3392
#define XCD_BAR_WORDS 3456
#define XB_SPIN_CAP (1u << 18)

__device__ __forceinline__ unsigned xb_ld(unsigned* p)              { return __hip_atomic_load(p, __ATOMIC_RELAXED, __HIP_MEMORY_SCOPE_AGENT); }
__device__ __forceinline__ unsigned xb_add(unsigned* p, unsigned v) { return __hip_atomic_fetch_add(p, v, __ATOMIC_RELAXED, __HIP_MEMORY_SCOPE_AGENT); }
__device__ __forceinline__ unsigned xb_xcc_id() { return (unsigned)__builtin_amdgcn_s_getreg((3 << 11) | 20) & 0xFu; }
#define XB_SPIN(cond, bar) do { unsigned _sp = 0; while (cond) { __builtin_amdgcn_s_sleep(1); \
    if ((++_sp & 255u) == 0u) { if (xb_ld(&(bar)[XB_TMO])) break; if (_sp > XB_SPIN_CAP) { atomicAdd(&(bar)[XB_TMO], 1u); break; } } } } while (0)

struct XcdBarrier {
    unsigned* bar; unsigned x;
    volatile LAS unsigned* st;
};

__device__ __forceinline__ XcdBarrier xcd_barrier_post(unsigned* bar, volatile LAS unsigned* st) {
    XcdBarrier b; b.bar = bar; b.x = xb_xcc_id(); b.st = st;
    if (threadIdx.x == 0) (void)xb_add(&bar[XB_XCNT(b.x)], 1u);
    return b;
}
__device__ __forceinline__ void xcd_barrier_complete(unsigned* bar, unsigned x, unsigned& nloc, unsigned& nx) {
    const unsigned G = gridDim.x * gridDim.y * gridDim.z;
    unsigned sum, cnt, mine, sp = 0u;
    for (;;) {
        sum = 0u; cnt = 0u; mine = 0u;
#pragma unroll
        for (unsigned j = 0; j < 16; ++j) { const unsigned c = xb_ld(&bar[XB_XCNT(j)]); sum += c; cnt += (c > 0u) ? 1u : 0u; mine = (j == x) ? c : mine; }
        if (sum == G) break;
        __builtin_amdgcn_s_sleep(1);
        if ((++sp & 255u) == 0u) { if (xb_ld(&bar[XB_TMO])) break; if (sp > XB_SPIN_CAP) { atomicAdd(&bar[XB_TMO], 1u); break; } }
    }
    nloc = mine > 0u ? mine : 1u; nx = cnt > 0u ? cnt : 1u;
}

__device__ __forceinline__ void xcd_barrier(const XcdBarrier& b) {
    asm volatile("s_waitcnt vmcnt(0)" ::: "memory");
    __syncthreads();
    if (threadIdx.x == 0) {
        unsigned* bar = b.bar;
        __builtin_amdgcn_s_waitcnt(0);
        unsigned nloc = b.st[0], nx = b.st[1];
        if (nloc == 0u) { xcd_barrier_complete(bar, b.x, nloc, nx); b.st[0] = nloc; b.st[1] = nx; }
        const unsigned old = xb_add(&bar[XB_XSUB(b.x)], 1u);
        const unsigned gen = old / nloc;
        if (old + 1u == (gen + 1u) * nloc) {
            __builtin_amdgcn_fence(__ATOMIC_RELEASE, "agent");
            asm volatile("s_waitcnt vmcnt(0)" ::: "memory");
            const unsigned og = xb_add(&bar[XB_TOP], 1u);
            const unsigned tg = og / nx;
            if (og + 1u == (tg + 1u) * nx) xb_add(&bar[XB_TOPGEN], 1u);
            else XB_SPIN(xb_ld(&bar[XB_TOPGEN]) == tg, bar);
            __builtin_amdgcn_fence(__ATOMIC_ACQUIRE, "agent");
            xb_add(&bar[XB_XGEN(b.x)], 1u);
            asm volatile("s_waitcnt vmcnt(0)" ::: "memory");
        } else {
            XB_SPIN(xb_ld(&bar[XB_XGEN(b.x)]) == gen, bar);
            __builtin_amdgcn_fence(__ATOMIC_ACQUIRE, "agent");
            asm volatile("s_waitcnt vmcnt(0)" ::: "memory");
        }
    }
    __syncthreads();
}

__device__ __forceinline__ void xcd_local_barrier(unsigned* ctl, unsigned x) {
    asm volatile("s_waitcnt vmcnt(0)" ::: "memory");
    __syncthreads();
    if (threadIdx.x == 0) {
        __builtin_amdgcn_s_waitcnt(0);
        const unsigned old = xb_add(&ctl[5120 + 64 * x], 1u), gen = old / 32u;
        if (old + 1u == (gen + 1u) * 32u) xb_add(&ctl[6144 + 64 * x], 1u);
        else XB_SPIN(xb_ld(&ctl[6144 + 64 * x]) == gen, ctl);
        __builtin_amdgcn_fence(__ATOMIC_ACQUIRE, "agent");
        asm volatile("s_waitcnt vmcnt(0)" ::: "memory");
    }
    __syncthreads();
}

__global__ void __launch_bounds__(NWAVES * 64, 2) hybrid_fwd(Params P) {
    extern __shared__ __attribute__((aligned(16))) unsigned char lds_raw[];
    cg::grid_group grid = cg::this_grid();
    LAS unsigned char* lds = (LAS unsigned char*)lds_raw;
    const int tid = threadIdx.x, lane = tid & 63, wave = __builtin_amdgcn_readfirstlane(tid >> 6);
    const int G = gridDim.x, bx = blockIdx.x;
    bf16* WinT = (bf16*)(P.ws + WS_WIN); bf16* WoT = (bf16*)(P.ws + WS_WO); bf16* WguT = (bf16*)(P.ws + WS_WGU); bf16* WdT = (bf16*)(P.ws + WS_WD);
    bf16* H = (bf16*)(P.ws + WS_H); bf16* MIX = (bf16*)(P.ws + WS_MIX); bf16* CAT = (bf16*)(P.ws + WS_CAT); bf16* ACT = (bf16*)(P.ws + WS_ACT);

    volatile LAS unsigned* bst = (volatile LAS unsigned*)(lds + 131072 + 512);
    if (tid < 2) bst[tid] = 0u;
    if (tid >= 64 && tid < 68) ((volatile LAS unsigned*)(lds + 131072 + 1024))[tid - 64] = 0u;
    __syncthreads();
    const XcdBarrier bar = xcd_barrier_post((unsigned*)(P.ws + WS_CTL), bst);
    if (P.use_cg_sync) grid.sync();
    unsigned* ctl = (unsigned*)(P.ws + WS_CTL);
    volatile LAS unsigned* vinfo = (volatile LAS unsigned*)(lds + 131072 + 1536);
    if (tid == 0) vinfo[0] = xb_add(&ctl[4096 + 64 * bar.x], 1u);
#define GRID_BAR() xcd_barrier(bar)
    p0_prologue(P, lds, tid, lane, wave);
    if (DUP == 1) { __syncthreads(); p0_prologue(P, lds, tid, lane, wave); }
    if (DUP == 11) { __syncthreads(); p0_prologue(P, lds, tid, lane, wave, 1); }
    if (DUP == 12) { __syncthreads(); p0_prologue(P, lds, tid, lane, wave, 2); }
    GRID_BAR();
    if (tid == 0) { bool ok = bar.x < 8u;
        for (unsigned j = 0; j < 16; ++j) ok = ok && (xb_ld(&ctl[XB_XCNT(j)]) == (j < 8u ? 32u : 0u));
        vinfo[1] = ok ? 1u : 0u; }
    __syncthreads();
    const bool xloc = vinfo[1] != 0u;
    const int vb = xloc ? (int)(bar.x * 32u + vinfo[0]) : bx;
    const int vc = xloc ? (int)(vinfo[0] * 8u + bar.x) : bx;
#undef GRID_BAR
#define GRID_BAR() do { if (xloc) xcd_local_barrier(ctl, bar.x); else xcd_barrier(bar); } while (0)
    if (DUP == 50 && xloc && (bar.x & 1u)) { const unsigned long long t0_ = __builtin_amdgcn_s_memrealtime(); while (__builtin_amdgcn_s_memrealtime() - t0_ < 4000ull) __builtin_amdgcn_s_sleep(8); }
    p1_rows(P, lds, tid, lane, wave, vb);
    if (DUP == 2) p1_rows(P, lds, tid, lane, wave, vb);
    GRID_BAR();
    {
        { pg8::Gemm g{H, WinT, M, PROJ_LD, D}; pg8::StaticOrder S; S.init(M, PROJ_LD, G, vc);
          pg8::EpiQKU E{ACT, C2};
          pg8::gemm_phase<pg8::EpiQKU, pg8::StaticOrder, PG8_ALIGN, PG8_SP2>(lds, g, S, E); }
        { pg8::Gemm g{WinT + (size_t)PROJ_LD * D, H, SBW, M, D}; pg8::StaticOrder S; S.init(SBW, M, G, vc);
          pg8::EpiVT E{ACT};
          pg8::gemm_phase<pg8::EpiVT, pg8::StaticOrder, PG8_ALIGN, PG8_SP2>(lds, g, S, E); }
        if (DUP == 20) { pg8::Gemm g{H, WinT, M, PROJ_LD, D}; pg8::StaticOrder S; S.init(M, PROJ_LD, G, vc);
          pg8::EpiQKU E{ACT, C2};
          pg8::gemm_phase<pg8::EpiQKU, pg8::StaticOrder, PG8_ALIGN, PG8_SP2>(lds, g, S, E); }
        if (DUP == 21) { pg8::Gemm g{WinT + (size_t)PROJ_LD * D, H, SBW, M, D}; pg8::StaticOrder S; S.init(SBW, M, G, vc);
          pg8::EpiVT E{ACT};
          pg8::gemm_phase<pg8::EpiVT, pg8::StaticOrder, PG8_ALIGN, PG8_SP2>(lds, g, S, E); }
    }
    GRID_BAR();
    p3_mixers(P, lds, tid, lane, wave, vb);
    if (DUP == 3) p3_mixers(P, lds, tid, lane, wave, vb, 3 + 4);
    if (DUP == 31) p3_mixers(P, lds, tid, lane, wave, vb, 1 + 4);
    if (DUP == 33) p3_mixers(P, lds, tid, lane, wave, vb, 1 + 8);
    if (DUP == 34) p3_mixers(P, lds, tid, lane, wave, vb, 1 + 16);
    if (DUP == 32) p3_mixers(P, lds, tid, lane, wave, vb, 2);
    GRID_BAR();
    {
        pg8::Gemm g{CAT, WoT, M, D, D}; pg8::StaticOrder S; S.init(M, D, G, vc);
        pg8::EpiBf16<0> E{MIX, D, nullptr, 0, 0, 1.f};
        pg8::gemm_phase<pg8::EpiBf16<0>, pg8::StaticOrder, PG8_ALIGN, PG8_SP2>(lds, g, S, E);
        if (DUP == 4) pg8::gemm_phase<pg8::EpiBf16<0>, pg8::StaticOrder, PG8_ALIGN, PG8_SP2>(lds, g, S, E);
    }
    GRID_BAR();
    p5_rows(P, lane, wave, vb);
    if (DUP == 5) p5_rows(P, lane, wave, vb);
    GRID_BAR();
    {
        pg8::Gemm g{H, WguT, M, 2 * DFF, D}; pg8::StaticOrder S; S.init(M, 2 * DFF, G, vc);
        pg8::EpiSwiGLU E{ACT, DFF};
        pg8::gemm_phase<pg8::EpiSwiGLU, pg8::StaticOrder, PG8_ALIGN, PG8_SP2>(lds, g, S, E);
        if (DUP == 6) pg8::gemm_phase<pg8::EpiSwiGLU, pg8::StaticOrder, PG8_ALIGN, PG8_SP2>(lds, g, S, E);
    }
    GRID_BAR();
    {
        pg8::Gemm g{ACT, WdT, M, D, DFF}; pg8::StaticOrder S; S.init(M, D, G, vc);
        pg8::EpiBf16<0> E{MIX, D, nullptr, 0, 0, 1.f};
        pg8::gemm_phase<pg8::EpiBf16<0>, pg8::StaticOrder, PG8_ALIGN, PG8_SP2>(lds, g, S, E);
        if (DUP == 7) pg8::gemm_phase<pg8::EpiBf16<0>, pg8::StaticOrder, PG8_ALIGN, PG8_SP2>(lds, g, S, E);
    }
    GRID_BAR();
    if (DUP == 9) { for (int i = 0; i < 16; ++i) GRID_BAR(); }
    p8_rows(P, lane, wave, vb);
}

extern "C" void kernel_launch(void* const* d_in, const int* in_sizes, int n_in, void* d_out, int out_size, void* d_ws, size_t ws_size, hipStream_t stream) {
    static int grid = 0;
    if (grid == 0) {
        if (n_in != 15 || in_sizes[0] != M * D || out_size != M * D || ws_size < WS_END) { fprintf(stderr, "kernel_launch: unexpected shapes (n_in %d, in0 %d, out %d, ws %zu); nothing launched\n", n_in, n_in > 0 ? in_sizes[0] : -1, out_size, ws_size); grid = -1; return; }
        int dev = 0, cus = 0, per_cu = 0;
        if (hipGetDevice(&dev) != hipSuccess || hipDeviceGetAttribute(&cus, hipDeviceAttributeMultiprocessorCount, dev) != hipSuccess) { grid = -1; return; }
        if (hipFuncSetAttribute((const void*)hybrid_fwd, hipFuncAttributeMaxDynamicSharedMemorySize, LDS_BYTES) != hipSuccess) { fprintf(stderr, "kernel_launch: hipFuncSetAttribute failed\n"); grid = -1; return; }
        if (hipOccupancyMaxActiveBlocksPerMultiprocessor(&per_cu, (const void*)hybrid_fwd, NWAVES * 64, LDS_BYTES) != hipSuccess || per_cu < 1) { fprintf(stderr, "kernel_launch: occupancy query says %d blocks per CU\n", per_cu); per_cu = 1; }
        (void)hipGetLastError();
        grid = cus * per_cu;
        if (grid != 256) { fprintf(stderr, "kernel_launch: built for a 256-workgroup cooperative grid (256 CUs x 1 workgroup), got %d x %d; nothing launched\n", cus, per_cu); grid = -1; return; }
    }
    if (grid < 0) return;
    if (hipMemsetAsync((char*)d_ws + WS_CTL, 0, CTL_BYTES, stream) != hipSuccess) { fprintf(stderr, "kernel_launch: memset of the barrier words failed\n"); return; }
    Params p{};
    p.x = (const float*)d_in[0]; p.c = (const float*)d_in[1]; p.w_cond = (const float*)d_in[2]; p.b_cond = (const float*)d_in[3]; p.g_mix_pre = (const float*)d_in[4]; p.g_mix_post = (const float*)d_in[5];
    p.w_in = (const float*)d_in[6]; p.w_pool = (const float*)d_in[7]; p.pool_scale = (const float*)d_in[8]; p.w_out = (const float*)d_in[9]; p.g_ffn_pre = (const float*)d_in[10]; p.g_ffn_post = (const float*)d_in[11];
    p.w_gate = (const float*)d_in[12]; p.w_up = (const float*)d_in[13]; p.w_down = (const float*)d_in[14];
    p.out = (float*)d_out; p.ws = (unsigned char*)d_ws;
    void* args[] = {&p};
    const hipError_t e = hipLaunchCooperativeKernel((const void*)hybrid_fwd, dim3(grid), dim3(NWAVES * 64), args, LDS_BYTES, stream);
    if (e != hipSuccess) fprintf(stderr, "kernel_launch: cooperative launch failed: %s (grid %d)\n", hipGetErrorString(e), grid);
}
```
